# Optimizing an MI355X kernel written in HIP

```python
import math
import jax, jax.numpy as jnp
from jax import lax
import numpy as np

D_MODEL = 1024
BATCH = 32
SEQ = 2048
DEPTH = 1

HEAD_DIM = 64
MIX_WIDTH = D_MODEL
A_WIDTH = MIX_WIDTH // 2
A_Q_HEADS = A_WIDTH // HEAD_DIM
A_KV_HEADS = A_Q_HEADS // 4
A_GROUP = A_Q_HEADS // A_KV_HEADS
A_KV_WIDTH = A_KV_HEADS * HEAD_DIM
WINDOW = 128
BLOCK = 128
SPAN = BLOCK + 2 * WINDOW
B_WIDTH = MIX_WIDTH - A_WIDTH
B_HEADS = B_WIDTH // (2 * HEAD_DIM)
B_VDIM = 2 * HEAD_DIM

ROPE_THETA = 10000.0
EPS = 1e-6
SCALE = 1.0 / math.sqrt(HEAD_DIM)
NEG = -1e30

IN_SIZES = (A_WIDTH, A_KV_WIDTH, A_KV_WIDTH, A_WIDTH, B_WIDTH, B_WIDTH, B_WIDTH, B_WIDTH)
IN_WIDTH = sum(IN_SIZES)
IN_SPLITS = tuple(int(v) for v in np.cumsum(IN_SIZES)[:-1])

kernel_name = "hymba_swa_sink_diffattn_adaln_encoder"


def _lambda_init(layer_idx):
    return 0.8 - 0.6 * math.exp(-0.3 * layer_idx)


def _rmsnorm(x, gain):
    xf = x.astype(jnp.float32)
    y = xf * lax.rsqrt(jnp.mean(xf * xf, axis=-1, keepdims=True) + EPS)
    return (y * gain.astype(jnp.float32)).astype(x.dtype)


def _rope_tables(positions):
    inv_freq = 1.0 / (ROPE_THETA ** (jnp.arange(0, HEAD_DIM, 2, dtype=jnp.float32) / HEAD_DIM))
    ang = positions.astype(jnp.float32)[..., None] * inv_freq
    ang = jnp.concatenate([ang, ang], axis=-1)
    return jnp.cos(ang), jnp.sin(ang)


def _rope(x, cos, sin):
    shape = cos.shape[:2] + (1,) * (x.ndim - 3) + (HEAD_DIM,)
    cos = cos.reshape(shape)
    sin = sin.reshape(shape)
    xf = x.astype(jnp.float32)
    x1, x2 = jnp.split(xf, 2, axis=-1)
    rot = jnp.concatenate([-x2, x1], axis=-1)
    return (xf * cos + rot * sin).astype(x.dtype)


def _windowed_gqa_sink(q, k, v, sink):
    B, S = q.shape[0], q.shape[1]
    nblk = S // BLOCK
    kp = jnp.pad(k, ((0, 0), (WINDOW, WINDOW), (0, 0), (0, 0)))
    vp = jnp.pad(v, ((0, 0), (WINDOW, WINDOW), (0, 0), (0, 0)))
    qblocks = jnp.moveaxis(q.reshape(B, nblk, BLOCK, A_KV_HEADS, A_GROUP, HEAD_DIM), 1, 0)
    sink_f = sink.astype(jnp.float32)[None, :, :, None, None]

    def one_block(args):
        i, qb = args
        start = i * BLOCK
        kb = lax.dynamic_slice_in_dim(kp, start, SPAN, axis=1)
        vb = lax.dynamic_slice_in_dim(vp, start, SPAN, axis=1)
        s = jnp.einsum('bqkgd,bjkd->bkgqj', qb, kb).astype(jnp.float32) * SCALE
        qpos = start + jnp.arange(BLOCK)
        kpos = start - WINDOW + jnp.arange(SPAN)
        valid = (kpos[None, :] >= 0) & (kpos[None, :] < S) & (jnp.abs(qpos[:, None] - kpos[None, :]) <= WINDOW)
        s = jnp.where(valid, s, NEG)
        m = jnp.maximum(jnp.max(s, axis=-1, keepdims=True), sink_f)
        p = jnp.exp(s - m)
        p = p / (jnp.sum(p, axis=-1, keepdims=True) + jnp.exp(sink_f - m))
        return jnp.einsum('bkgqj,bjkd->bqkgd', p.astype(vb.dtype), vb)

    o = lax.map(one_block, (jnp.arange(nblk), qblocks))
    return jnp.moveaxis(o, 0, 1).reshape(B, S, A_WIDTH)


def _diff_attention(q, k, v, lam, subln_gain, lambda_init):
    B, S = q.shape[0], q.shape[1]
    nblk = S // BLOCK
    qblocks = jnp.moveaxis(q.reshape(B, nblk, BLOCK, B_HEADS, 2, HEAD_DIM), 1, 0)

    def one_block(qb):
        s = jnp.einsum('bqhcd,bjhcd->bhcqj', qb, k).astype(jnp.float32) * SCALE
        p = jax.nn.softmax(s, axis=-1)
        attn = p[:, :, 0] - lam * p[:, :, 1]
        return jnp.einsum('bhqj,bjhe->bqhe', attn.astype(v.dtype), v)

    o = lax.map(one_block, qblocks)
    o = jnp.moveaxis(o, 0, 1).reshape(B, S, B_HEADS, B_VDIM)
    o = _rmsnorm(o, subln_gain) * (1.0 - lambda_init)
    return o.reshape(B, S, B_WIDTH)


def _layer(x, c, cos, sin, w_ada, b_ada, norm_gain, w_in, q_norm_a, k_norm_a, sink_a,
           q_norm_b, k_norm_b, lambda_q1, lambda_k1, lambda_q2, lambda_k2, subln_gain, w_out,
           lambda_init):
    B, S, _ = x.shape
    mod = jax.nn.silu(c) @ w_ada + b_ada
    shift, scale, gate = jnp.split(mod, 3, axis=-1)
    h = _rmsnorm(x, norm_gain) * (1.0 + scale[:, None, :]) + shift[:, None, :]
    proj = h @ w_in
    qa, ka, va, ga, qb, kb, vb, gb = jnp.split(proj, IN_SPLITS, axis=-1)

    qa = _rope(_rmsnorm(qa.reshape(B, S, A_KV_HEADS, A_GROUP, HEAD_DIM), q_norm_a), cos, sin)
    ka = _rope(_rmsnorm(ka.reshape(B, S, A_KV_HEADS, HEAD_DIM), k_norm_a), cos, sin)
    va = va.reshape(B, S, A_KV_HEADS, HEAD_DIM)
    ya = _windowed_gqa_sink(qa, ka, va, sink_a.reshape(A_KV_HEADS, A_GROUP))

    qb = _rope(_rmsnorm(qb.reshape(B, S, B_HEADS, 2, HEAD_DIM), q_norm_b), cos, sin)
    kb = _rope(_rmsnorm(kb.reshape(B, S, B_HEADS, 2, HEAD_DIM), k_norm_b), cos, sin)
    vb = vb.reshape(B, S, B_HEADS, B_VDIM)
    f32 = jnp.float32
    lam = (jnp.exp(jnp.sum(lambda_q1.astype(f32) * lambda_k1.astype(f32)))
           - jnp.exp(jnp.sum(lambda_q2.astype(f32) * lambda_k2.astype(f32))) + lambda_init)
    yb = _diff_attention(qb, kb, vb, lam, subln_gain, lambda_init)

    y = jnp.concatenate([ya * jax.nn.silu(ga), yb * jax.nn.silu(gb)], axis=-1) @ w_out
    return x + gate[:, None, :] * y


def setup_inputs(seed: int = 0) -> dict:
    key = jax.random.key(seed)
    ks = jax.random.split(key, 20)
    f32 = jnp.float32
    nrm = lambda k, shape, s: jax.random.normal(k, shape, f32) * s
    L = DEPTH
    return {
        "x": nrm(ks[0], (BATCH, SEQ, D_MODEL), 1.0),
        "c": nrm(ks[1], (BATCH, D_MODEL), 1.0),
        "positions": (jnp.arange(SEQ, dtype=jnp.int32)[None, :]
                      + jax.random.randint(ks[2], (BATCH, 1), 0, 4096, dtype=jnp.int32)),
        "w_ada": nrm(ks[3], (L, D_MODEL, 3 * D_MODEL), D_MODEL ** -0.5),
        "b_ada": nrm(ks[4], (L, 3 * D_MODEL), 0.02),
        "norm_gain": 1.0 + nrm(ks[5], (L, D_MODEL), 0.05),
        "w_in": nrm(ks[6], (L, D_MODEL, IN_WIDTH), D_MODEL ** -0.5),
        "q_norm_a": 1.0 + nrm(ks[7], (L, HEAD_DIM), 0.05),
        "k_norm_a": 1.0 + nrm(ks[8], (L, HEAD_DIM), 0.05),
        "sink_a": nrm(ks[9], (L, A_Q_HEADS), 0.5),
        "q_norm_b": 1.0 + nrm(ks[10], (L, HEAD_DIM), 0.05),
        "k_norm_b": 1.0 + nrm(ks[11], (L, HEAD_DIM), 0.05),
        "lambda_q1": nrm(ks[12], (L, HEAD_DIM), 0.1),
        "lambda_k1": nrm(ks[13], (L, HEAD_DIM), 0.1),
        "lambda_q2": nrm(ks[14], (L, HEAD_DIM), 0.1),
        "lambda_k2": nrm(ks[15], (L, HEAD_DIM), 0.1),
        "subln_gain": 1.0 + nrm(ks[16], (L, B_VDIM), 0.05),
        "w_out": nrm(ks[17], (L, MIX_WIDTH, D_MODEL), MIX_WIDTH ** -0.5),
    }


def reference(x, c, positions, w_ada, b_ada, norm_gain, w_in, q_norm_a, k_norm_a, sink_a,
              q_norm_b, k_norm_b, lambda_q1, lambda_k1, lambda_q2, lambda_k2, subln_gain, w_out):
    cos, sin = _rope_tables(positions)
    h = x
    for l in range(DEPTH):
        h = _layer(h, c, cos, sin, w_ada[l], b_ada[l], norm_gain[l], w_in[l], q_norm_a[l],
                   k_norm_a[l], sink_a[l], q_norm_b[l], k_norm_b[l], lambda_q1[l], lambda_k1[l],
                   lambda_q2[l], lambda_k2[l], subln_gain[l], w_out[l], _lambda_init(l))
    return h
```

```cpp
#include <hip/hip_runtime.h>
#include <hip/hip_cooperative_groups.h>
#include <cstdio>
#include <cstdint>
namespace cg = cooperative_groups;
#ifndef WGM_G1
#define WGM_G1 4
#endif
#ifndef WGM_G2
#define WGM_G2 4
#endif
#ifndef REP0
#define REP0 1
#endif
#ifndef REP1
#define REP1 1
#endif
#ifndef REP2
#define REP2 1
#endif
#ifndef REP3A
#define REP3A 1
#endif
#ifndef REP3B
#define REP3B 1
#endif
#ifndef REP4
#define REP4 1
#endif

namespace pg8 {
#define PG8_LAS __attribute__((address_space(3)))
typedef unsigned short bf16_t;
typedef short bf16x8 __attribute__((ext_vector_type(8)));
typedef float f32x4 __attribute__((ext_vector_type(4)));
typedef unsigned u32x4 __attribute__((ext_vector_type(4)));
constexpr int BM = 256, BK = 64, HALF = 128, HTB = HALF * BK * 2  , STAGE_BYTES = 8 * HTB, NXCD = 8;

__host__ __device__ __forceinline__ int lds_byte(int r, int c) { const int st = (r >> 4) * 2 + (c >> 5), rr = r & 15, cc = c & 31, ob = rr * 64 + cc * 2; return st * 1024 + (ob ^ (((ob >> 9) & 1) << 5)); }
__host__ __device__ __forceinline__ void stage_rc(int b, int& R, int& C) { const int st = b / 1024, sb = b % 1024, swz = sb ^ (((sb >> 9) & 1) << 5); R = (st >> 1) * 16 + swz / 64; C = (st & 1) * 32 + (swz % 64) / 2; }
__host__ __device__ __forceinline__ int perm32(int rho) { const int n = rho >> 4, i = rho & 15; return 8 * (i >> 2) + 4 * n + (i & 3); }

struct Unit { int pm, pn; };
struct Gemm { const bf16_t* A; const bf16_t* Bt; int M, N, K; };

struct StaticOrder {
    int nM, nN, nwg, G, c, WGM;
    __host__ __device__ void init(int M, int N, int G_, int c_, int wgm_ = 8) { nM = M / BM; nN = N / BM; nwg = nM * nN; G = G_; c = c_; WGM = wgm_; }
    __host__ __device__ bool next(int i, Unit& u) const {
        const long L = (long)i * G + c; if (L >= nwg) return false;
        int wgid = (int)L; { const int q = nwg / NXCD, r = nwg % NXCD, xcd = wgid % NXCD, off = wgid / NXCD; wgid = (xcd < r ? xcd * (q + 1) : r * (q + 1) + (xcd - r) * q) + off; }
        const int nig = WGM * nN, gid = wgid / nig, fm = gid * WGM, gsz = (nM - fm) < WGM ? (nM - fm) : WGM;
        u.pm = fm + ((wgid % nig) % gsz); u.pn = (wgid % nig) / gsz; return true;
    }
    __device__ __forceinline__ void a_ready(const Unit&) const {}
    __device__ __forceinline__ void done(const Unit&) const {}
};

typedef float f32x2 __attribute__((ext_vector_type(2)));
typedef __bf16 bf16x2_t __attribute__((ext_vector_type(2)));
__device__ __forceinline__ unsigned cvt_pk_bf16(float lo, float hi) { f32x2 v = {lo, hi}; bf16x2_t b = __builtin_convertvector(v, bf16x2_t); return __builtin_bit_cast(unsigned, b); }

constexpr int PROJ_W = 3328;
constexpr float QSCALE = 0.125f * 1.4426950408889634f;
constexpr float RMS_EPS = 1e-6f;

struct EpiProj {
    static constexpr bool PERM = true, AFTER_DRAIN = false;
    bf16_t* O; const float* rope; const float *gqa, *gka, *gqb, *gkb;
    __device__ __forceinline__ void operator()(const f32x4 (&acc)[2][2][4][2], const Unit& u, int wr, int wc, int fr, int fq) const {
        const int colh = u.pn * 256 + wc * 64;
        int mode; const float* gain = gqa; float osc = 1.f;
        if (colh < 512) { mode = 1; gain = gqa; osc = QSCALE; }
        else if (colh < 640) { mode = 1; gain = gka; }
        else if (colh < 768) mode = 0;
        else if (colh < 1280) mode = 2;
        else if (colh < 1792) { mode = 1; gain = gqb; osc = QSCALE; }
        else if (colh < 2304) { mode = 1; gain = gkb; }
        else if (colh < 2816) mode = 0;
        else mode = 2;
        const int row0 = u.pm * BM + wr * 64 + fr;
        if (mode == 1) {
            f32x4 g[2][2];
#pragma unroll
            for (int bj = 0; bj < 2; ++bj)
#pragma unroll
                for (int n = 0; n < 2; ++n) g[bj][n] = *(const f32x4*)(gain + 32 * bj + 8 * fq + 4 * n) * osc;
            f32x4 rc[4], rn[4];
#define ROPE_LOAD(dst, g_) do { const float* rp_ = rope + (size_t)(row0 + ((g_) >> 2) * HALF + ((g_) & 3) * 16) * 64 + 8 * fq; \
                dst[0] = *(const f32x4*)(rp_); dst[1] = *(const f32x4*)(rp_ + 4); dst[2] = *(const f32x4*)(rp_ + 32); dst[3] = *(const f32x4*)(rp_ + 36); } while (0)
            ROPE_LOAD(rc, 0);
#pragma unroll
            for (int gi = 0; gi < 8; ++gi) {
                const int ai = gi >> 2, m = gi & 3;
                if (gi < 7) ROPE_LOAD(rn, gi + 1);
                const int row = row0 + ai * HALF + m * 16;
                const f32x4 c0 = rc[0], c1 = rc[1], s0 = rc[2], s1 = rc[3];
                float ss = 0.f;
#pragma unroll
                for (int bj = 0; bj < 2; ++bj)
#pragma unroll
                    for (int n = 0; n < 2; ++n) { const f32x4 v = acc[ai][bj][m][n]; ss += (v[0] * v[0] + v[1] * v[1]) + (v[2] * v[2] + v[3] * v[3]); }
                ss += __shfl_xor(ss, 16); ss += __shfl_xor(ss, 32);
                const float rstd = rsqrtf(ss * (1.0f / 64.0f) + RMS_EPS);
                const f32x4 a0 = acc[ai][0][m][0] * rstd * g[0][0], a1 = acc[ai][0][m][1] * rstd * g[0][1];
                const f32x4 b0 = acc[ai][1][m][0] * rstd * g[1][0], b1 = acc[ai][1][m][1] * rstd * g[1][1];
                const f32x4 o00 = a0 * c0 - b0 * s0, o01 = a1 * c1 - b1 * s1, o10 = b0 * c0 + a0 * s0, o11 = b1 * c1 + a1 * s1;
                bf16_t* op = O + (size_t)row * PROJ_W + colh + 8 * fq;
                u32x4 w; w.x = cvt_pk_bf16(o00[0], o00[1]); w.y = cvt_pk_bf16(o00[2], o00[3]); w.z = cvt_pk_bf16(o01[0], o01[1]); w.w = cvt_pk_bf16(o01[2], o01[3]);
                *(u32x4*)op = w;
                w.x = cvt_pk_bf16(o10[0], o10[1]); w.y = cvt_pk_bf16(o10[2], o10[3]); w.z = cvt_pk_bf16(o11[0], o11[1]); w.w = cvt_pk_bf16(o11[2], o11[3]);
                *(u32x4*)(op + 32) = w;
#pragma unroll
                for (int k = 0; k < 4; ++k) rc[k] = rn[k];
            }
#undef ROPE_LOAD
        } else {
#pragma unroll
            for (int ai = 0; ai < 2; ++ai)
#pragma unroll
                for (int m = 0; m < 4; ++m) {
                    const int row = row0 + ai * HALF + m * 16;
                    bf16_t* op = O + (size_t)row * PROJ_W + colh + 8 * fq;
#pragma unroll
                    for (int bj = 0; bj < 2; ++bj) {
                        f32x4 v0 = acc[ai][bj][m][0], v1 = acc[ai][bj][m][1];
                        if (mode == 2) {
#pragma unroll
                            for (int j = 0; j < 4; ++j) { v0[j] = v0[j] * __builtin_amdgcn_rcpf(1.0f + __builtin_amdgcn_exp2f(-1.4426950408889634f * v0[j])); v1[j] = v1[j] * __builtin_amdgcn_rcpf(1.0f + __builtin_amdgcn_exp2f(-1.4426950408889634f * v1[j])); }
                        }
                        u32x4 w; w.x = cvt_pk_bf16(v0[0], v0[1]); w.y = cvt_pk_bf16(v0[2], v0[3]); w.z = cvt_pk_bf16(v1[0], v1[1]); w.w = cvt_pk_bf16(v1[2], v1[3]);
                        *(u32x4*)(op + 32 * bj) = w;
                    }
                }
        }
    }
};

struct EpiOut {
    static constexpr bool PERM = true, AFTER_DRAIN = false;
    const float* __restrict__ x; float* __restrict__ out; const float* __restrict__ gate;
    __device__ __forceinline__ void operator()(const f32x4 (&acc)[2][2][4][2], const Unit& u, int wr, int wc, int fr, int fq) const {
        const int row0 = u.pm * BM + wr * 64 + fr, col0 = u.pn * BM + wc * 32 + 8 * fq;
        const float* gp = gate + (size_t)(u.pm >> 3) * 3072 + col0;
        f32x4 gv[2][2];
#pragma unroll
        for (int bj = 0; bj < 2; ++bj)
#pragma unroll
            for (int n = 0; n < 2; ++n) gv[bj][n] = *(const f32x4*)(gp + bj * HALF + 4 * n);
        f32x4 xc[2][2][2], xn[2][2][2];
#define EPI_LOAD(dst, b) do { _Pragma("unroll") for (int mm = 0; mm < 2; ++mm) { const size_t off_ = (size_t)(row0 + ((b) >> 1) * HALF + (2 * ((b) & 1) + mm) * 16) * 1024 + col0; \
            _Pragma("unroll") for (int bj = 0; bj < 2; ++bj) _Pragma("unroll") for (int n = 0; n < 2; ++n) dst[mm][bj][n] = __builtin_nontemporal_load((const f32x4*)(x + off_ + bj * HALF + 4 * n)); } } while (0)
        EPI_LOAD(xc, 0);
#pragma unroll
        for (int b = 0; b < 4; ++b) {
            if (b < 3) EPI_LOAD(xn, b + 1);
#pragma unroll
            for (int mm = 0; mm < 2; ++mm) {
                const size_t off = (size_t)(row0 + (b >> 1) * HALF + (2 * (b & 1) + mm) * 16) * 1024 + col0;
#pragma unroll
                for (int bj = 0; bj < 2; ++bj)
#pragma unroll
                    for (int n = 0; n < 2; ++n) *(f32x4*)(out + off + bj * HALF + 4 * n) = xc[mm][bj][n] + gv[bj][n] * acc[b >> 1][bj][2 * (b & 1) + mm][n];
            }
#pragma unroll
            for (int mm = 0; mm < 2; ++mm)
#pragma unroll
                for (int bj = 0; bj < 2; ++bj)
#pragma unroll
                    for (int n = 0; n < 2; ++n) xc[mm][bj][n] = xn[mm][bj][n];
        }
#undef EPI_LOAD
    }
};

template <class Epi, class Sched, bool ALIGN_EPI = false, bool SP2 = false>
__device__ __forceinline__ void gemm_phase(PG8_LAS unsigned char* lds, const Gemm g, const Sched& S, const Epi& E) {
    const int tid = threadIdx.x, wid = __builtin_amdgcn_readfirstlane(tid >> 6), lane = tid & 63, wr = wid >> 2, wc = wid & 3, fr = lane & 15, fq = lane >> 4;
    const int K = g.K, nt = K / BK;
    unsigned voffA[2], voffB[2];
#pragma unroll
    for (int i = 0; i < 2; ++i) { int R, C; stage_rc(tid * 16 + i * 8192, R, C); const int Rb = Epi::PERM ? ((R & ~31) + perm32(R & 31)) : R;
        voffA[i] = (unsigned)(R * K + C) * 2u; voffB[i] = (unsigned)(Rb * K + C) * 2u; }
    const size_t kstep = (size_t)(BK * 2);
    const size_t hstep = (size_t)HALF * K * 2;
    const size_t tstep = 2 * hstep;
    const unsigned ldsw = (unsigned)wid * 1024u;
    const int aoff = lds_byte(wr * 64 + fr, fq * 8), boff = lds_byte(wc * 32 + fr, fq * 8);
#define PG8_SA(b, h) (((b) * 2 + (h)) * HTB)
#define PG8_SB(b, h) ((4 + (b) * 2 + (h)) * HTB)
#define PG8_STAGE(bufoff, gbase, voff) do { _Pragma("unroll") for (int _i = 0; _i < 2; ++_i) \
        __builtin_amdgcn_global_load_lds((const unsigned*)((const char*)(gbase) + (voff)[_i]), (PG8_LAS unsigned*)(lds + (bufoff) + ldsw + _i * 8192), 16, 0, 0); } while (0)
#define PG8_LDA(dst, b, h) do { _Pragma("unroll") for (int m = 0; m < 4; ++m) _Pragma("unroll") for (int k = 0; k < 2; ++k) dst[m][k] = *(const PG8_LAS bf16x8*)(lds + PG8_SA(b, h) + aoff + m * 2048 + k * 1024); } while (0)
#define PG8_LDB(dst, b, h) do { _Pragma("unroll") for (int n = 0; n < 2; ++n) _Pragma("unroll") for (int k = 0; k < 2; ++k) dst[n][k] = *(const PG8_LAS bf16x8*)(lds + PG8_SB(b, h) + boff + n * 2048 + k * 1024); } while (0)
#define PG8_MMA(ai, bj, At, Bt) do { __builtin_amdgcn_s_setprio(1); _Pragma("unroll") for (int m = 0; m < 4; ++m) _Pragma("unroll") for (int n = 0; n < 2; ++n) _Pragma("unroll") for (int k = 0; k < 2; ++k) \
        acc[ai][bj][m][n] = __builtin_amdgcn_mfma_f32_16x16x32_bf16(Bt[n][k], At[m][k], acc[ai][bj][m][n], 0, 0, 0); __builtin_amdgcn_s_setprio(0); } while (0)
#define PG8_WAIT_V(n) asm volatile("s_waitcnt vmcnt(" #n ")" ::: "memory")
#define PG8_WAIT_L(n) asm volatile("s_waitcnt lgkmcnt(" #n ")" ::: "memory")
#define PG8_BAR __builtin_amdgcn_s_barrier()
#define PG8_SCHED __builtin_amdgcn_sched_barrier(0)
    Unit cur, nxt; int ui = 0;
    if (!S.next(0, cur)) return;
    f32x4 acc[2][2][4][2];
#pragma unroll
    for (int a = 0; a < 2; ++a)
#pragma unroll
        for (int b = 0; b < 2; ++b)
#pragma unroll
            for (int m = 0; m < 4; ++m)
#pragma unroll
                for (int n = 0; n < 2; ++n) acc[a][b][m][n] = (f32x4){0.f, 0.f, 0.f, 0.f};
    bf16x8 At[4][2], B0[2][2], B1[2][2];
    const char* cA = (const char*)g.A + (size_t)cur.pm * tstep; const char* cB = (const char*)g.Bt + (size_t)cur.pn * tstep;
    S.a_ready(cur);
    if constexpr (SP2) {
        PG8_STAGE(PG8_SB(0, 0), cB, voffB); PG8_STAGE(PG8_SB(0, 1), cB + hstep, voffB); PG8_STAGE(PG8_SA(0, 0), cA, voffA); PG8_STAGE(PG8_SA(0, 1), cA + hstep, voffA);
        if (wr == 1) PG8_BAR;
        PG8_WAIT_V(2); PG8_BAR;
        PG8_STAGE(PG8_SB(1, 0), cB + kstep, voffB); PG8_STAGE(PG8_SA(1, 0), cA + kstep, voffA); PG8_STAGE(PG8_SB(1, 1), cB + hstep + kstep, voffB);
        PG8_WAIT_V(6); PG8_BAR;
    } else {
        PG8_STAGE(PG8_SB(0, 0), cB, voffB); PG8_STAGE(PG8_SA(0, 0), cA, voffA); PG8_STAGE(PG8_SB(0, 1), cB + hstep, voffB); PG8_STAGE(PG8_SA(0, 1), cA + hstep, voffA);
        if (wr == 1) PG8_BAR;
        PG8_WAIT_V(4); PG8_BAR;
        PG8_STAGE(PG8_SB(1, 0), cB + kstep, voffB); PG8_STAGE(PG8_SA(1, 0), cA + kstep, voffA); PG8_STAGE(PG8_SB(1, 1), cB + hstep + kstep, voffB);
        PG8_WAIT_V(6); PG8_BAR;
    }
    for (;;) {
        const bool has_next = S.next(ui + 1, nxt);
        const char* nA = has_next ? (const char*)g.A + (size_t)nxt.pm * tstep : cA; const char* nB = has_next ? (const char*)g.Bt + (size_t)nxt.pn * tstep : cB;
        for (int t = 0; t < nt; t += 2) {
            const bool last = (t == nt - 2);
            const char* a1 = cA + (size_t)(t + 1) * kstep;
            const char* a2 = last ? nA : cA + (size_t)(t + 2) * kstep; const char* b2 = last ? nB : cB + (size_t)(t + 2) * kstep;
            const char* a3 = a2 + kstep; const char* b3 = b2 + kstep;
            if (last && has_next) S.a_ready(nxt);
            if constexpr (SP2) {
            PG8_LDB(B0, 0, 0); PG8_LDB(B1, 0, 1); PG8_SCHED; PG8_LDA(At, 0, 0); PG8_STAGE(PG8_SA(1, 1), a1 + hstep, voffA);
            PG8_WAIT_V(8); PG8_WAIT_L(0); PG8_BAR; PG8_MMA(0, 0, At, B0); PG8_MMA(0, 1, At, B1); PG8_BAR; PG8_SCHED;
            PG8_LDA(At, 0, 1); PG8_STAGE(PG8_SB(0, 0), b2, voffB); PG8_STAGE(PG8_SB(0, 1), b2 + hstep, voffB); PG8_STAGE(PG8_SA(0, 0), a2, voffA);
            PG8_WAIT_V(8); PG8_WAIT_L(0); PG8_BAR; PG8_MMA(1, 0, At, B0); PG8_MMA(1, 1, At, B1); PG8_BAR; PG8_SCHED;
            PG8_LDB(B0, 1, 0); PG8_LDB(B1, 1, 1); PG8_SCHED; PG8_LDA(At, 1, 0); PG8_STAGE(PG8_SA(0, 1), a2 + hstep, voffA);
            PG8_WAIT_V(8); PG8_WAIT_L(0); PG8_BAR; PG8_MMA(0, 0, At, B0); PG8_MMA(0, 1, At, B1); PG8_BAR; PG8_SCHED;
            PG8_LDA(At, 1, 1); PG8_STAGE(PG8_SB(1, 0), b3, voffB); PG8_STAGE(PG8_SB(1, 1), b3 + hstep, voffB); PG8_STAGE(PG8_SA(1, 0), a3, voffA);
            PG8_WAIT_V(8); PG8_WAIT_L(0); PG8_BAR; PG8_MMA(1, 0, At, B0); PG8_MMA(1, 1, At, B1); PG8_BAR; PG8_SCHED;
            } else {
            PG8_LDB(B0, 0, 0); PG8_SCHED; PG8_LDA(At, 0, 0); PG8_STAGE(PG8_SA(1, 1), a1 + hstep, voffA);
            PG8_WAIT_L(8); PG8_BAR; PG8_WAIT_L(0); PG8_MMA(0, 0, At, B0); PG8_BAR; PG8_SCHED;
            PG8_LDB(B1, 0, 1); PG8_STAGE(PG8_SB(0, 0), b2, voffB);
            PG8_BAR; PG8_WAIT_L(0); PG8_MMA(0, 1, At, B1); PG8_BAR;
            PG8_LDA(At, 0, 1); PG8_STAGE(PG8_SA(0, 0), a2, voffA);
            PG8_BAR; PG8_WAIT_L(0); PG8_MMA(1, 0, At, B0); PG8_BAR; PG8_SCHED;
            PG8_STAGE(PG8_SB(0, 1), b2 + hstep, voffB);
            PG8_WAIT_V(6); PG8_BAR; PG8_MMA(1, 1, At, B1); PG8_BAR;
            PG8_LDB(B0, 1, 0); PG8_SCHED; PG8_LDA(At, 1, 0); PG8_STAGE(PG8_SA(0, 1), a2 + hstep, voffA);
            PG8_WAIT_L(8); PG8_BAR; PG8_WAIT_L(0); PG8_MMA(0, 0, At, B0); PG8_BAR; PG8_SCHED;
            PG8_LDB(B1, 1, 1); PG8_STAGE(PG8_SB(1, 0), b3, voffB);
            PG8_BAR; PG8_WAIT_L(0); PG8_MMA(0, 1, At, B1); PG8_BAR;
            PG8_LDA(At, 1, 1); PG8_STAGE(PG8_SA(1, 0), a3, voffA);
            PG8_BAR; PG8_WAIT_L(0); PG8_MMA(1, 0, At, B0); PG8_BAR; PG8_SCHED;
            PG8_STAGE(PG8_SB(1, 1), b3 + hstep, voffB);
            PG8_WAIT_V(6); PG8_BAR; PG8_MMA(1, 1, At, B1); PG8_BAR;
            }
        }
        if constexpr (ALIGN_EPI) { if (wr == 0) PG8_BAR; }
        if constexpr (!Epi::AFTER_DRAIN) { E(acc, cur, wr, wc, fr, fq); S.done(cur); }
        if (!has_next) break;
#pragma unroll
        for (int a = 0; a < 2; ++a)
#pragma unroll
            for (int b = 0; b < 2; ++b)
#pragma unroll
                for (int m = 0; m < 4; ++m)
#pragma unroll
                    for (int n = 0; n < 2; ++n) acc[a][b][m][n] = (f32x4){0.f, 0.f, 0.f, 0.f};
        cur = nxt; cA = nA; cB = nB; ++ui;
        if constexpr (ALIGN_EPI) { if (wr == 1) PG8_BAR; }
    }
    PG8_WAIT_V(0);
    if constexpr (!ALIGN_EPI) { if (wr == 0) PG8_BAR; }
    PG8_BAR;
    if constexpr (Epi::AFTER_DRAIN) { E.fused(acc, cur, wr, wc, fr, fq, lds, wid, lane); S.done(cur); }
#undef PG8_SA
#undef PG8_SB
#undef PG8_STAGE
#undef PG8_LDA
#undef PG8_LDB
#undef PG8_MMA
#undef PG8_WAIT_V
#undef PG8_WAIT_L
#undef PG8_BAR
#undef PG8_SCHED
}
}

constexpr int D_MODEL = 1024, BATCH = 32, SEQ = 2048, MROWS = BATCH * SEQ;
constexpr int NWAVES = 8, NTHREADS = 512;
constexpr float LOG2E = 1.4426950408889634f;
constexpr float RMS_EPS_ = 1e-6f;
constexpr float LAMBDA_INIT = 0.2f;
constexpr int C_QA = 0, C_KA = 512, C_VA = 640, C_GA = 768, C_QB = 1280, C_KB = 1792, C_VB = 2304, C_GB = 2816;

#define LAS __attribute__((address_space(3)))
typedef unsigned short bf16_t;
typedef short bf16x8 __attribute__((ext_vector_type(8)));
typedef short s16x4 __attribute__((ext_vector_type(4)));
typedef float f32x4 __attribute__((ext_vector_type(4)));
typedef float f32x16 __attribute__((ext_vector_type(16)));
typedef unsigned u32x4 __attribute__((ext_vector_type(4)));
typedef unsigned u32x2 __attribute__((ext_vector_type(2)));
using pg8::cvt_pk_bf16; using pg8::PROJ_W;

constexpr size_t MiB = 1u << 20;
constexpr size_t WS_MODP = 0;
constexpr size_t WS_CTL = 12 * MiB, CTL_BYTES = 16384;
constexpr size_t WS_MOD = 8 * MiB;
constexpr size_t WS_WIN = 16 * MiB;
constexpr size_t WS_WOUT = 24 * MiB;
constexpr size_t WS_ROPE = 32 * MiB;
constexpr size_t WS_H = 64 * MiB;
constexpr size_t WS_Y = WS_H;
constexpr size_t WS_PROJ = 192 * MiB;
constexpr size_t WS_END = WS_PROJ + (size_t)MROWS * 3328 * 2;

constexpr int LDS_BYTES = 147456;

__device__ __forceinline__ float wave_sum(float v) {
#pragma unroll
    for (int o = 1; o < 64; o <<= 1) v += __shfl_xor(v, o);
    return v;
}
__device__ __forceinline__ unsigned f2bf(float f) { unsigned u = __builtin_bit_cast(unsigned, f); return (u + 0x7fffu + ((u >> 16) & 1u)) >> 16; }
__device__ __forceinline__ unsigned pk2(float lo, float hi) { return cvt_pk_bf16(lo, hi); }
__device__ __forceinline__ float bf_lo(unsigned w) { return __builtin_bit_cast(float, w << 16); }
__device__ __forceinline__ float bf_hi(unsigned w) { return __builtin_bit_cast(float, w & 0xffff0000u); }

__device__ __forceinline__ void p0_transpose_item(const float* W, int K, int N, bf16_t* WT, bool headperm, LAS float* scr, int item, int lane) {
    const int nblk = N / 32, kb = item / nblk, nb = item % nblk, k0 = 64 * kb, n0 = 32 * nb;
    const int prow0 = headperm ? ((n0 & ~255) + 128 * ((n0 >> 5) & 1) + 32 * ((n0 >> 6) & 3)) : n0;
#pragma unroll 8
    for (int i = 0; i < 32; ++i) { const int kk = 2 * i + (lane >> 5); scr[kk * 33 + (lane & 31)] = W[(size_t)(k0 + kk) * N + n0 + (lane & 31)]; }
    __builtin_amdgcn_s_waitcnt(0xc07f); asm volatile("s_waitcnt lgkmcnt(0)" ::: "memory");
    const int c = lane & 7;
#pragma unroll
    for (int j = 0; j < 4; ++j) { const int n = (lane >> 3) + 8 * j; const LAS float* s = scr + (8 * c) * 33 + n;
        u32x4 o; o.x = pk2(s[0 * 33], s[1 * 33]); o.y = pk2(s[2 * 33], s[3 * 33]); o.z = pk2(s[4 * 33], s[5 * 33]); o.w = pk2(s[6 * 33], s[7 * 33]);
        *(u32x4*)(WT + (size_t)(prow0 + n) * K + k0 + 8 * c) = o; }
    asm volatile("s_waitcnt lgkmcnt(0)" ::: "memory");
}

__device__ __forceinline__ void p0_mod_item(const float* c, const float* w_ada, float* modp, LAS float* scr, int item, int lane) {
    const int kc = item / 48, cgp = item % 48, k0 = kc * 64, n = cgp * 64 + lane;
    float w[64];
#pragma unroll
    for (int k = 0; k < 64; ++k) w[k] = w_ada[(size_t)(k0 + k) * 3072 + n];
    {
        const int b = lane & 31, kh = lane >> 5;
#pragma unroll 8
        for (int kk = 0; kk < 32; ++kk) { const int k = 2 * kk + kh; const float v = c[b * 1024 + k0 + k]; scr[k * 32 + b] = v / (1.0f + __expf(-v)); }
    }
    asm volatile("s_waitcnt lgkmcnt(0)" ::: "memory");
    float acc[32];
#pragma unroll
    for (int b = 0; b < 32; ++b) acc[b] = 0.f;
#pragma unroll
    for (int k = 0; k < 64; ++k) {
#pragma unroll
        for (int b4 = 0; b4 < 8; ++b4) { const f32x4 sv = *(const LAS f32x4*)(scr + k * 32 + 4 * b4); acc[4 * b4] += sv[0] * w[k]; acc[4 * b4 + 1] += sv[1] * w[k]; acc[4 * b4 + 2] += sv[2] * w[k]; acc[4 * b4 + 3] += sv[3] * w[k]; }
    }
#pragma unroll
    for (int b = 0; b < 32; ++b) modp[((size_t)kc * 32 + b) * 3072 + n] = acc[b];
    asm volatile("s_waitcnt lgkmcnt(0)" ::: "memory");
}

__device__ __forceinline__ void p0_rope(const int* positions, float* rope, int idx, float inv_freq) {
    const int r = idx >> 5, i = idx & 31;
    const float angf = (float)positions[r] * inv_freq;
    const double a = (double)angf;
    const double nq = rint(a * 0.63661977236758134308);
    const double rr = (a - nq * 1.57079632679489655800) - nq * 6.12323399573676603587e-17;
    const double r2 = rr * rr;
    const double sn = rr * (1.0 + r2 * (-1.0 / 6 + r2 * (1.0 / 120 + r2 * (-1.0 / 5040 + r2 * (1.0 / 362880 + r2 * (-1.0 / 39916800 + r2 * (1.0 / 6227020800.0)))))));
    const double cs = 1.0 + r2 * (-0.5 + r2 * (1.0 / 24 + r2 * (-1.0 / 720 + r2 * (1.0 / 40320 + r2 * (-1.0 / 3628800 + r2 * (1.0 / 479001600 + r2 * (-1.0 / 87178291200.0)))))));
    const int q = ((int)(long long)nq) & 3;
    const double s = (q == 0) ? sn : (q == 1) ? cs : (q == 2) ? -sn : -cs;
    const double cc = (q == 0) ? cs : (q == 1) ? -sn : (q == 2) ? -cs : sn;
    rope[(size_t)r * 64 + i] = (float)cc; rope[(size_t)r * 64 + 32 + i] = (float)s;
}

struct Ptrs {
    const float *x, *c; const int* positions; const float *w_ada, *b_ada, *norm_gain, *w_in, *q_norm_a, *k_norm_a, *sink_a, *q_norm_b, *k_norm_b, *lq1, *lk1, *lq2, *lk2, *subln, *w_out;
    float* out; unsigned char* ws; int ph_lo, ph_hi;
};

__device__ __forceinline__ void phase0(const Ptrs& P, LAS unsigned char* lds, int wave, int lane) {
    LAS float* scr = (LAS float*)(lds + wave * 16384);
    const int gw = blockIdx.x * NWAVES + wave, NGW = gridDim.x * NWAVES;
    constexpr int I_MOD = 16 * 48, I_IN = (1024 / 64) * (3328 / 32), I_OUT = (1024 / 64) * (1024 / 32);
    constexpr int NITEMS = I_MOD + I_IN + I_OUT;
    float* modp = (float*)(P.ws + WS_MODP);
    const int nmodw = (NGW >= 2 * I_MOD) ? I_MOD : 0;
    if (gw < nmodw) p0_mod_item(P.c, P.w_ada, modp, scr, gw, lane);
    else {
        for (int it = gw - nmodw + (nmodw ? I_MOD : 0); it < NITEMS; it += NGW - nmodw) {
            int r = it;
            if (r < I_MOD) { p0_mod_item(P.c, P.w_ada, modp, scr, r, lane); continue; } r -= I_MOD;
            if (r < I_IN) { p0_transpose_item(P.w_in, 1024, 3328, (bf16_t*)(P.ws + WS_WIN), true, scr, r, lane); continue; } r -= I_IN;
            p0_transpose_item(P.w_out, 1024, 1024, (bf16_t*)(P.ws + WS_WOUT), false, scr, r, lane);
        }
    }
    float* rope = (float*)(P.ws + WS_ROPE);
    const float inv_freq = 1.0f / powf(10000.0f, (float)(2 * (threadIdx.x & 31)) / 64.0f);
    for (int idx = blockIdx.x * NTHREADS + threadIdx.x; idx < MROWS * 32; idx += gridDim.x * NTHREADS) p0_rope(P.positions, rope, idx, inv_freq);
}

__device__ __forceinline__ void phase1(const Ptrs& P, LAS unsigned char* lds, int wave, int lane) {
    LAS float* sh_gs = (LAS float*)lds;
    LAS float* sh_sf = (LAS float*)(lds + 4096);
    const float* modp = (const float*)(P.ws + WS_MODP);
    float* mod = (float*)(P.ws + WS_MOD);
    bf16_t* H = (bf16_t*)(P.ws + WS_H);
    for (int t = blockIdx.x; t < MROWS / 256; t += gridDim.x) {
        const int b = t >> 3;
        __syncthreads();
        for (int n = threadIdx.x; n < 3072; n += NTHREADS) {
            if (n >= 2048 && (t & 7) != 0) break;
            float s = P.b_ada[n];
#pragma unroll
            for (int kc = 0; kc < 16; ++kc) s += modp[((size_t)kc * 32 + b) * 3072 + n];
            if (n < 1024) sh_sf[n] = s;
            else if (n < 2048) sh_gs[n - 1024] = P.norm_gain[n - 1024] * (1.0f + s);
            else mod[(size_t)b * 3072 + n] = s;
        }
        __syncthreads();
        f32x4 v[4][4], vn[4][4];
        {
            const f32x4* xr = (const f32x4*)(P.x + ((size_t)t * 256 + wave * 32) * 1024) + lane;
#pragma unroll
            for (int q = 0; q < 4; ++q)
#pragma unroll
                for (int j = 0; j < 4; ++j) v[q][j] = __builtin_nontemporal_load(xr + q * 256 + 64 * j);
        }
        for (int rr = 0; rr < 32; rr += 4) {
            const size_t row = (size_t)t * 256 + wave * 32 + rr;
            if (rr + 4 < 32) {
                const f32x4* xr = (const f32x4*)(P.x + (row + 4) * 1024) + lane;
#pragma unroll
                for (int q = 0; q < 4; ++q)
#pragma unroll
                    for (int j = 0; j < 4; ++j) vn[q][j] = __builtin_nontemporal_load(xr + q * 256 + 64 * j);
            }
            float s[4];
#pragma unroll
            for (int q = 0; q < 4; ++q) { s[q] = 0.f;
#pragma unroll
                for (int j = 0; j < 4; ++j) s[q] += (v[q][j].x * v[q][j].x + v[q][j].y * v[q][j].y) + (v[q][j].z * v[q][j].z + v[q][j].w * v[q][j].w); }
#pragma unroll
            for (int o = 1; o < 64; o <<= 1) {
#pragma unroll
                for (int q = 0; q < 4; ++q) s[q] += __shfl_xor(s[q], o); }
#pragma unroll
            for (int q = 0; q < 4; ++q) {
                const float rstd = rsqrtf(s[q] * (1.f / 1024) + RMS_EPS_);
                u32x2* o8 = (u32x2*)(H + (row + q) * 1024) + lane;
#pragma unroll
                for (int j = 0; j < 4; ++j) {
                    const f32x4 g = *(const LAS f32x4*)(sh_gs + 256 * j + 4 * lane), sf = *(const LAS f32x4*)(sh_sf + 256 * j + 4 * lane);
                    const f32x4 hv = v[q][j] * rstd * g + sf;
                    u32x2 w; w.x = pk2(hv.x, hv.y); w.y = pk2(hv.z, hv.w); o8[64 * j] = w;
                }
            }
#pragma unroll
            for (int q = 0; q < 4; ++q)
#pragma unroll
                for (int j = 0; j < 4; ++j) v[q][j] = vn[q][j];
        }
    }
}

__device__ __forceinline__ unsigned off_b(unsigned row, unsigned ch) { return 256u * row + 16u * (ch ^ (((row & 3) << 2) | ((row >> 2) & 3))); }
__device__ __forceinline__ int crow(int r, int hi) { return (r & 3) + 8 * (r >> 2) + 4 * hi; }
__device__ __forceinline__ s16x4 vtr(const LAS unsigned char* p) { typedef short v4i16_t __attribute__((ext_vector_type(4))); return __builtin_bit_cast(s16x4, __builtin_amdgcn_ds_read_tr16_b64_v4i16((LAS v4i16_t*)p)); }
#define MFMA32(a, b, c) __builtin_amdgcn_mfma_f32_32x32x16_bf16((a), (b), (c), 0, 0, 0)

typedef const LAS unsigned char* ldsp_t;
__device__ __forceinline__ ldsp_t lxor(ldsp_t p, unsigned c) { return (ldsp_t)((unsigned)(uintptr_t)p ^ c); }
template <int NEB, bool MASK, bool QLDS, int KCH0, int VCH0, int QCH0>
__device__ __forceinline__ void att_half(ldsp_t kaddr, ldsp_t vaddr, ldsp_t qaddr, const bf16x8 (&qf)[4], f32x16 (&o)[NEB], float& l, float negm, int hi, int dq0  ) {
    f32x16 s;
#pragma unroll
    for (int i = 0; i < 16; ++i) s[i] = negm;
#pragma unroll
    for (int ks = 0; ks < 4; ++ks) {
        const bf16x8 kf = *(const LAS bf16x8*)lxor(kaddr, 16u * (KCH0 + 2 * ks));
        bf16x8 qv;
        if (QLDS) qv = *(const LAS bf16x8*)lxor(qaddr, 16u * (QCH0 + 2 * ks)); else qv = qf[ks];
        s = MFMA32(kf, qv, s);
    }
    float sum = 0.f;
#pragma unroll
    for (int i = 0; i < 16; ++i) {
        float p = __builtin_amdgcn_exp2f(s[i]);
        if (MASK) { const int d = dq0 - crow(i, hi); p = (d <= 128 && d >= -128) ? p : 0.f; }
        s[i] = p; sum += p;
    }
    l += sum;
    u32x4 w0, w1;
    w0.x = cvt_pk_bf16(s[0], s[1]); w0.y = cvt_pk_bf16(s[2], s[3]); w0.z = cvt_pk_bf16(s[4], s[5]); w0.w = cvt_pk_bf16(s[6], s[7]);
    w1.x = cvt_pk_bf16(s[8], s[9]); w1.y = cvt_pk_bf16(s[10], s[11]); w1.z = cvt_pk_bf16(s[12], s[13]); w1.w = cvt_pk_bf16(s[14], s[15]);
    const bf16x8 pk0 = __builtin_bit_cast(bf16x8, w0), pk1 = __builtin_bit_cast(bf16x8, w1);
#pragma unroll
    for (int eb = 0; eb < NEB; ++eb) {
        const ldsp_t a0 = lxor(vaddr, 64u * (VCH0 / 4 + eb)), a1 = lxor(vaddr, (64u * (VCH0 / 4 + eb)) ^ 32u);
#pragma unroll
        for (int u = 0; u < 2; ++u) {
            const s16x4 lo = vtr(a0 + 4096 * u);
            const s16x4 hh = vtr(a1 + 4096 * u + 2048);
            const bf16x8 vf = (bf16x8){lo[0], lo[1], lo[2], lo[3], hh[0], hh[1], hh[2], hh[3]};
            o[eb] = MFMA32(vf, u == 0 ? pk0 : pk1, o[eb]);
        }
    }
}
__device__ __forceinline__ unsigned lane_kL(int r32, int hi) { const unsigned xk = ((r32 & 3) << 2) | ((r32 >> 2) & 3); return 256u * r32 + 16u * ((unsigned)hi ^ xk); }
__device__ __forceinline__ unsigned lane_vL(int lane, int hi) { const unsigned blk = (lane >> 4) & 1, q = (lane & 15) >> 2, p = lane & 3; return 256u * (4 * hi + q) + 64u * q + ((32u * blk + 16u * (p >> 1)) ^ (16u * hi)) + 8u * (p & 1); }

__device__ __forceinline__ void glds16(const void* gsrc, unsigned lds_dst) { unsigned keep;
    asm volatile("s_mov_b32 %0, m0\n\ts_mov_b32 m0, %2\n\ts_nop 0\n\tglobal_load_lds_dwordx4 %1, off\n\ts_mov_b32 m0, %0" : "=&s"(keep) : "v"(gsrc), "s"(lds_dst) : "memory"); }
__device__ __forceinline__ f32x16 qk_half(ldsp_t kaddr, const bf16x8 (&qf)[4], float negm) {
    f32x16 s;
#pragma unroll
    for (int i = 0; i < 16; ++i) s[i] = negm;
#pragma unroll
    for (int ks = 0; ks < 4; ++ks) { const bf16x8 kf = *(const LAS bf16x8*)lxor(kaddr, 32u * ks); s = MFMA32(kf, qf[ks], s); }
    return s;
}
__device__ __forceinline__ void exp_pack(f32x16& s, float& l, bf16x8& pk0, bf16x8& pk1) {
    float sum = 0.f;
#pragma unroll
    for (int i = 0; i < 16; ++i) { s[i] = __builtin_amdgcn_exp2f(s[i]); sum += s[i]; }
    l += sum;
    u32x4 w0, w1;
    w0.x = cvt_pk_bf16(s[0], s[1]); w0.y = cvt_pk_bf16(s[2], s[3]); w0.z = cvt_pk_bf16(s[4], s[5]); w0.w = cvt_pk_bf16(s[6], s[7]);
    w1.x = cvt_pk_bf16(s[8], s[9]); w1.y = cvt_pk_bf16(s[10], s[11]); w1.z = cvt_pk_bf16(s[12], s[13]); w1.w = cvt_pk_bf16(s[14], s[15]);
    pk0 = __builtin_bit_cast(bf16x8, w0); pk1 = __builtin_bit_cast(bf16x8, w1);
}
template <int NEB, int VB = 0>
__device__ __forceinline__ void pv_half(ldsp_t vaddr, const bf16x8 pk0, const bf16x8 pk1, f32x16 (&o)[NEB]) {
#pragma unroll
    for (int eb = 0; eb < NEB; ++eb) {
        const ldsp_t a0 = lxor(vaddr, 64u * (VB + eb)), a1 = lxor(vaddr, (64u * (VB + eb)) ^ 32u);
#pragma unroll
        for (int u = 0; u < 2; ++u) {
            const s16x4 lo = vtr(a0 + 4096 * u);
            const s16x4 hh = vtr(a1 + 4096 * u + 2048);
            const bf16x8 vf = (bf16x8){lo[0], lo[1], lo[2], lo[3], hh[0], hh[1], hh[2], hh[3]};
            o[eb] = MFMA32(vf, u == 0 ? pk0 : pk1, o[eb]);
        }
    }
}

__device__ __forceinline__ void attnB_stream(LAS unsigned char* lds, const bf16_t* proj, bf16_t* y, const float* subln, int u0, int ustride, int nunits, float negm, float lam) {
    const int tid = threadIdx.x, lane = tid & 63, wid = __builtin_amdgcn_readfirstlane(tid >> 6), r32 = lane & 31, hi = lane >> 5;
    const int c = wid >> 2, rg = wid & 3;
    const int img = wid >> 2;
    unsigned goff[4];
#pragma unroll
    for (int i = 0; i < 4; ++i) goff[i] = (unsigned)((16 * (wid & 3) + 4 * i + (lane >> 4)) * PROJ_W + 8 * ((lane & 15) ^ (((lane >> 4) << 2) | i))) * 2u;
    const unsigned dst0 = img * 16384 + (4 * (wid & 3)) * 1024;
    const unsigned ldsbase = (unsigned)(uintptr_t)lds;
#define UNIT_GSRC(u) ((const char*)(proj + (size_t)((u) >> 6) * SEQ * PROJ_W + (img ? C_VB : C_KB) + 128 * (((u) >> 4) & 3)))
#define DMA_TILE(gs0, t, bufoff) do { const char* gs_ = (gs0) + (size_t)(t) * (64 * PROJ_W * 2); _Pragma("unroll") for (int i_ = 0; i_ < 4; ++i_) \
        glds16(gs_ + goff[i_], (unsigned)__builtin_amdgcn_readfirstlane(ldsbase + (bufoff) + dst0 + i_ * 1024)); } while (0)
#define LOAD_Q(u) do { const bf16_t* qp_ = proj + ((size_t)((u) >> 6) * SEQ + ((u) & 15) * 128 + rg * 32 + r32) * PROJ_W + C_QB + 128 * (((u) >> 4) & 3) + 64 * c + 8 * hi; \
        _Pragma("unroll") for (int s_ = 0; s_ < 4; ++s_) qf[s_] = *(const bf16x8*)(qp_ + 16 * s_); } while (0)
    LAS float* sh_gain = (LAS float*)(lds + 131072 + 2048);
    if (tid < 128) sh_gain[tid] = subln[tid];
    if (u0 >= nunits) return;
    int b0 = 0, b1 = 32768, b2 = 65536;
    bf16x8 qf[4];
    { const char* g0 = UNIT_GSRC(u0); DMA_TILE(g0, 0, b0); DMA_TILE(g0, 1, b1); LOAD_Q(u0); }
    unsigned kL = lane_kL(r32, hi) ^ (128u * c), vL = lane_vL(lane, hi);
    for (int u = u0; u < nunits; u += ustride) {
        const int un = u + ustride; const bool has_next = un < nunits;
        const char* gcur = UNIT_GSRC(u); const char* gnxt = UNIT_GSRC(has_next ? un : u);
        const int qb = u & 15, h = (u >> 4) & 3, b = u >> 6;
        const size_t qrow = (size_t)b * SEQ + qb * 128 + rg * 32 + r32;
        f32x16 o[4];
#pragma unroll
        for (int e = 0; e < 4; ++e)
#pragma unroll
            for (int i = 0; i < 16; ++i) o[e][i] = 0.f;
        float l = 0.f;
        if (u == u0) asm volatile("s_waitcnt vmcnt(0)" ::: "memory");
        __syncthreads();
#define SB_STAGE() __builtin_amdgcn_sched_barrier(0x2 | 0x4 | 0x400)
#define KLOAD(dst, base) do { _Pragma("unroll") for (int ks_ = 0; ks_ < 4; ++ks_) dst[ks_] = *(const LAS bf16x8*)lxor((base), 32u * ks_); } while (0)
#define VLOAD(dst, base, eb0) do { _Pragma("unroll") for (int e_ = 0; e_ < 2; ++e_) { const ldsp_t a0_ = lxor((base), 64u * ((eb0) + e_)), a1_ = lxor((base), (64u * ((eb0) + e_)) ^ 32u); \
            _Pragma("unroll") for (int u_ = 0; u_ < 2; ++u_) { const s16x4 lo_ = vtr(a0_ + 4096 * u_); const s16x4 hh_ = vtr(a1_ + 4096 * u_ + 2048); \
                dst[e_][u_] = (bf16x8){lo_[0], lo_[1], lo_[2], lo_[3], hh_[0], hh_[1], hh_[2], hh_[3]}; } } } while (0)
#define QKMMA(sd, kf) do { _Pragma("unroll") for (int ks_ = 0; ks_ < 4; ++ks_) sd = MFMA32(kf[ks_], qf[ks_], ks_ == 0 ? negv : sd); } while (0)
#define PVMMA(vf, eb0, p0, p1) do { _Pragma("unroll") for (int e_ = 0; e_ < 2; ++e_) { o[(eb0) + e_] = MFMA32(vf[e_][0], p0, o[(eb0) + e_]); o[(eb0) + e_] = MFMA32(vf[e_][1], p1, o[(eb0) + e_]); } } while (0)
        f32x16 negv;
#pragma unroll
        for (int i = 0; i < 16; ++i) negv[i] = negm;
        asm volatile("" : "+v"(negv));
        bf16x8 kfa[4], kfb[4], vfa[2][2], vfb[2][2], pa, pb, pc, pd;
        f32x16 s0, s1;
        KLOAD(kfa, lds + b0 + kL);
        KLOAD(kfb, lds + b0 + 8192 + kL);
        QKMMA(s0, kfa);
        for (int t = 0; t < 32; ++t) {
            asm volatile("" : "+v"(kL), "+v"(vL));
            if (t + 2 < 32) DMA_TILE(gcur, t + 2, b2); else if (has_next) DMA_TILE(gnxt, t - 30, b2);
            ldsp_t vb = lds + b0 + 16384 + vL, kn = lds + b1 + kL;
            VLOAD(vfa, vb, 0);
            QKMMA(s1, kfb);
            exp_pack(s0, l, pa, pb);
            SB_STAGE();
            VLOAD(vfb, vb, 2);
            PVMMA(vfa, 0, pa, pb);
            SB_STAGE();
            KLOAD(kfa, kn);
            PVMMA(vfb, 2, pa, pb);
            exp_pack(s1, l, pc, pd);
            SB_STAGE();
            VLOAD(vfa, vb + 8192, 0);
            QKMMA(s0, kfa);
            SB_STAGE();
            VLOAD(vfb, vb + 8192, 2);
            PVMMA(vfa, 0, pc, pd);
            SB_STAGE();
            KLOAD(kfb, kn + 8192);
            PVMMA(vfb, 2, pc, pd);
            asm volatile("s_waitcnt vmcnt(0)" ::: "memory");
            __syncthreads();
            const int tmp = b0; b0 = b1; b1 = b2; b2 = tmp;
        }
#undef SB_STAGE
#undef KLOAD
#undef VLOAD
#undef QKMMA
#undef PVMMA
        if (has_next) LOAD_Q(un);
        l += __shfl_xor(l, 32);
        LAS float* xch = (LAS float*)(lds + (rg < 2 ? b2 + rg * 16384 : 98304 + (rg - 2) * 16384)) + r32;
        const bf16_t* gp = proj + qrow * PROJ_W + C_GB + 128 * h + 8 * hi;
        if (c == 1) {
            const float i1 = lam / l;
#pragma unroll
            for (int e = 0; e < 4; ++e)
#pragma unroll
                for (int i = 0; i < 16; ++i) xch[(32 * e + crow(i, hi)) * 32] = o[e][i] * i1;
        }
        __syncthreads();
        if (c == 0) {
            u32x4 gc[2], gn2[2];
#pragma unroll
            for (int k = 0; k < 2; ++k) gc[k] = *(const u32x4*)(gp + 16 * k);
            const float i0 = 1.0f / l;
            float ss = 0.f;
#pragma unroll
            for (int e = 0; e < 4; ++e)
#pragma unroll
                for (int i = 0; i < 16; ++i) { const float v = o[e][i] * i0 - xch[(32 * e + crow(i, hi)) * 32]; o[e][i] = v; ss += v * v; }
            ss += __shfl_xor(ss, 32);
            const float rstd = rsqrtf(ss * (1.0f / 128.0f) + RMS_EPS_) * (1.0f - LAMBDA_INIT);
            bf16_t* yp16 = y + qrow * 1024 + 512 + 128 * h + 8 * hi;
#pragma unroll
            for (int e = 0; e < 4; ++e) {
                if (e < 3) {
#pragma unroll
                    for (int k = 0; k < 2; ++k) gn2[k] = *(const u32x4*)(gp + 32 * (e + 1) + 16 * k);
                }
#pragma unroll
                for (int k = 0; k < 2; ++k) {
                    float lo4[4], hi4[4];
#pragma unroll
                    for (int j = 0; j < 4; ++j) {
                        const auto r = __builtin_amdgcn_permlane32_swap(__float_as_uint(o[e][8 * k + j]), __float_as_uint(o[e][8 * k + 4 + j]), false, false);
                        lo4[j] = __uint_as_float(r[0]); hi4[j] = __uint_as_float(r[1]);
                    }
                    const f32x4 ga = *(const LAS f32x4*)(sh_gain + 32 * e + 16 * k + 8 * hi), gb = *(const LAS f32x4*)(sh_gain + 32 * e + 16 * k + 8 * hi + 4);
                    const u32x4 g4v = gc[k];
                    u32x4 w4;
                    w4.x = pk2(lo4[0] * rstd * ga[0] * bf_lo(g4v.x), lo4[1] * rstd * ga[1] * bf_hi(g4v.x)); w4.y = pk2(lo4[2] * rstd * ga[2] * bf_lo(g4v.y), lo4[3] * rstd * ga[3] * bf_hi(g4v.y));
                    w4.z = pk2(hi4[0] * rstd * gb[0] * bf_lo(g4v.z), hi4[1] * rstd * gb[1] * bf_hi(g4v.z)); w4.w = pk2(hi4[2] * rstd * gb[2] * bf_lo(g4v.w), hi4[3] * rstd * gb[3] * bf_hi(g4v.w));
                    *(u32x4*)(yp16 + 32 * e + 16 * k) = w4;
                }
#pragma unroll
                for (int k = 0; k < 2; ++k) gc[k] = gn2[k];
                asm volatile("" ::: "memory");
            }
        }
    }
#undef DMA_TILE
#undef UNIT_GSRC
#undef LOAD_Q
    __syncthreads();
}

__device__ __forceinline__ void attnA_strip(LAS unsigned char* lds, const bf16_t* proj, bf16_t* y, const float* sink, int b, int kvh, int qb0, int nq, float negm) {
    const int tid = threadIdx.x, lane = tid & 63, wid = __builtin_amdgcn_readfirstlane(tid >> 6), r32 = lane & 31, hi = lane >> 5;
    const size_t rowbase = (size_t)b * SEQ;
    const char* gsrc = (const char*)(proj + rowbase * PROJ_W);
    unsigned goff[2];
#pragma unroll
    for (int j = 0; j < 2; ++j) {
        const int blk = 2 * wid + j, row = 4 * blk + (lane >> 4);
        const int ch = (lane & 15) ^ (((lane >> 4) << 2) | (blk & 3));
        const int col = (ch < 8) ? (C_KA + 64 * kvh + 8 * ch) : (C_VA + 64 * kvh + 8 * (ch - 8));
        goff[j] = (unsigned)(row * PROJ_W + col) * 2u;
    }
    const unsigned ldsbase = (unsigned)(uintptr_t)lds;
#define DMA_TILE_A(kt) do { if ((kt) >= 0 && (kt) < 32) { const char* gs_ = gsrc + (size_t)(kt) * (64 * PROJ_W * 2); const unsigned so_ = ((kt) % 6) * 16384 + 2 * wid * 1024; \
        glds16(gs_ + goff[0], (unsigned)__builtin_amdgcn_readfirstlane(ldsbase + so_)); glds16(gs_ + goff[1], (unsigned)__builtin_amdgcn_readfirstlane(ldsbase + so_ + 1024)); } } while (0)
    for (int kt = qb0 - 2; kt <= qb0 + 2; ++kt) DMA_TILE_A(kt);
    const int g = wid & 3, rg = wid >> 2, head = 4 * kvh + g;
    const float sinkv = __builtin_amdgcn_exp2f(sink[head] * LOG2E + negm);
    unsigned kL = lane_kL(r32, hi), vL = lane_vL(lane, hi);
    bf16x8 qf[4];
    {
        const bf16_t* qp = proj + (rowbase + 64 * qb0 + 32 * rg + r32) * PROJ_W + C_QA + 64 * head + 8 * hi;
#pragma unroll
        for (int s = 0; s < 4; ++s) qf[s] = *(const bf16x8*)(qp + 16 * s);
    }
    for (int iq = 0; iq < nq; ++iq) {
        const int qb = qb0 + iq;
        const int qpos = 64 * qb + 32 * rg + r32;
        const size_t qrow = rowbase + qpos;
        f32x16 o[2];
#pragma unroll
        for (int e = 0; e < 2; ++e)
#pragma unroll
            for (int i = 0; i < 16; ++i) o[e][i] = 0.f;
        float l = 0.f;
        if (iq == 0) asm volatile("s_waitcnt vmcnt(0)" ::: "memory"); else asm volatile("s_waitcnt vmcnt(8)" ::: "memory");
        __syncthreads();
        if (iq + 1 < nq) DMA_TILE_A(qb + 3);
        const bf16_t* gp = proj + qrow * PROJ_W + C_GA + 64 * head + 8 * hi;
        u32x4 gt[2][2];
#pragma unroll
        for (int e = 0; e < 2; ++e)
#pragma unroll
            for (int k = 0; k < 2; ++k) gt[e][k] = *(const u32x4*)(gp + 32 * e + 16 * k);
        bf16x8 qn[4];
        {
            const bf16_t* qp = proj + (qrow + ((iq + 1 < nq) ? 64 : 0)) * PROJ_W + C_QA + 64 * head + 8 * hi;
#pragma unroll
            for (int s = 0; s < 4; ++s) qn[s] = *(const bf16x8*)(qp + 16 * s);
        }
        const int qw0 = 64 * qb + 32 * rg;
        const int i_lo = (qw0 - 128 < 0) ? ((128 - qw0) >> 5) : 0;
        const int i_hi = (qw0 + 128 > SEQ - 32) ? ((SEQ - 32 - qw0 + 128) >> 5) : 8;
#define HALF_IMG(i) (lds + (((qw0 - 128 + 32 * (i)) >> 6) % 6) * 16384 + (((qw0 - 128 + 32 * (i)) >> 5) & 1) * 8192)
#define KLOAD_A(dst, base) do { _Pragma("unroll") for (int ks_ = 0; ks_ < 4; ++ks_) dst[ks_] = *(const LAS bf16x8*)lxor((base), 32u * ks_); } while (0)
#define QK_A(sd, kf) do { _Pragma("unroll") for (int ks_ = 0; ks_ < 4; ++ks_) sd = MFMA32(kf[ks_], qf[ks_], ks_ == 0 ? negv : sd); } while (0)
        f32x16 negv;
#pragma unroll
        for (int r = 0; r < 16; ++r) negv[r] = negm;
        asm volatile("" : "+v"(negv));
        bf16x8 kfn[4], vf[2][2];
        f32x16 sc, sn;
        KLOAD_A(kfn, HALF_IMG(i_lo) + kL);
        QK_A(sc, kfn);
        if (i_lo < i_hi) KLOAD_A(kfn, HALF_IMG(i_lo + 1) + kL);
        for (int i = i_lo; i <= i_hi; ++i) {
            asm volatile("" : "+v"(kL), "+v"(vL));
            ldsp_t va = HALF_IMG(i) + vL;
#pragma unroll
            for (int eb = 0; eb < 2; ++eb) {
                const ldsp_t a0 = lxor(va, 64u * (2 + eb)), a1 = lxor(va, (64u * (2 + eb)) ^ 32u);
#pragma unroll
                for (int u = 0; u < 2; ++u) { const s16x4 lo = vtr(a0 + 4096 * u); const s16x4 hh = vtr(a1 + 4096 * u + 2048); vf[eb][u] = (bf16x8){lo[0], lo[1], lo[2], lo[3], hh[0], hh[1], hh[2], hh[3]}; }
            }
            sn = sc;
            if (i < i_hi) QK_A(sn, kfn);
            __builtin_amdgcn_sched_barrier(0x2 | 0x4 | 0x400);
            if (i + 1 < i_hi) KLOAD_A(kfn, HALF_IMG(i + 2) + kL);
#pragma unroll
            for (int r = 0; r < 16; ++r) sc[r] = __builtin_amdgcn_exp2f(sc[r]);
            if (i == 0 || i == 8) {
                const int dq0 = qpos - (qw0 - 128 + 32 * i);
#pragma unroll
                for (int r = 0; r < 16; ++r) { const int d = dq0 - crow(r, hi); sc[r] = (d <= 128 && d >= -128) ? sc[r] : 0.f; }
            }
            float sum = 0.f;
#pragma unroll
            for (int r = 0; r < 16; ++r) sum += sc[r];
            l += sum;
            u32x4 w0, w1;
            w0.x = cvt_pk_bf16(sc[0], sc[1]); w0.y = cvt_pk_bf16(sc[2], sc[3]); w0.z = cvt_pk_bf16(sc[4], sc[5]); w0.w = cvt_pk_bf16(sc[6], sc[7]);
            w1.x = cvt_pk_bf16(sc[8], sc[9]); w1.y = cvt_pk_bf16(sc[10], sc[11]); w1.z = cvt_pk_bf16(sc[12], sc[13]); w1.w = cvt_pk_bf16(sc[14], sc[15]);
            const bf16x8 pk0 = __builtin_bit_cast(bf16x8, w0), pk1 = __builtin_bit_cast(bf16x8, w1);
#pragma unroll
            for (int eb = 0; eb < 2; ++eb) { o[eb] = MFMA32(vf[eb][0], pk0, o[eb]); o[eb] = MFMA32(vf[eb][1], pk1, o[eb]); }
            sc = sn;
        }
#undef KLOAD_A
#undef QK_A
#undef HALF_IMG
        l += __shfl_xor(l, 32);
        l += sinkv;
        const float inv = 1.0f / l;
        bf16_t* yp16 = y + qrow * 1024 + 64 * head + 8 * hi;
#pragma unroll
        for (int e = 0; e < 2; ++e)
#pragma unroll
            for (int k = 0; k < 2; ++k) {
                float lo4[4], hi4[4];
#pragma unroll
                for (int j = 0; j < 4; ++j) {
                    const auto r = __builtin_amdgcn_permlane32_swap(__float_as_uint(o[e][8 * k + j]), __float_as_uint(o[e][8 * k + 4 + j]), false, false);
                    lo4[j] = __uint_as_float(r[0]); hi4[j] = __uint_as_float(r[1]);
                }
                const u32x4 g4v = gt[e][k];
                u32x4 w4;
                w4.x = pk2(lo4[0] * inv * bf_lo(g4v.x), lo4[1] * inv * bf_hi(g4v.x)); w4.y = pk2(lo4[2] * inv * bf_lo(g4v.y), lo4[3] * inv * bf_hi(g4v.y));
                w4.z = pk2(hi4[0] * inv * bf_lo(g4v.z), hi4[1] * inv * bf_hi(g4v.z)); w4.w = pk2(hi4[2] * inv * bf_lo(g4v.w), hi4[3] * inv * bf_hi(g4v.w));
                *(u32x4*)(yp16 + 32 * e + 16 * k) = w4;
            }
#pragma unroll
        for (int s = 0; s < 4; ++s) qf[s] = qn[s];
    }
#undef DMA_TILE_A
    __syncthreads();
}

__device__ __forceinline__ float absmax64(const float* g) { float m = 0.f; for (int i = 0; i < 64; ++i) m = fmaxf(m, fabsf(g[i])); return m; }

__device__ __forceinline__ void phase3(const Ptrs& P, LAS unsigned char* lds) {
    const bf16_t* proj = (const bf16_t*)(P.ws + WS_PROJ);
    bf16_t* y = (bf16_t*)(P.ws + WS_Y);
    const float negmA = -(8.0f * absmax64(P.q_norm_a) * absmax64(P.k_norm_a)) * LOG2E;
    const float negmB = -(8.0f * absmax64(P.q_norm_b) * absmax64(P.k_norm_b)) * LOG2E;
    float d1 = 0.f, d2 = 0.f;
    for (int i = 0; i < 64; ++i) { d1 += P.lq1[i] * P.lk1[i]; d2 += P.lq2[i] * P.lk2[i]; }
    const float lam = expf(d1) - expf(d2) + LAMBDA_INIT;
    const int vblk = ((gridDim.x & 7) == 0) ? (int)((blockIdx.x & 7) * (gridDim.x >> 3) + (blockIdx.x >> 3)) : (int)blockIdx.x;
#ifndef NO_ATTB
    for (int rep = 0; rep < REP3B; ++rep) attnB_stream(lds, proj, y, P.subln, vblk, (int)gridDim.x, BATCH * 4 * 16, negmB, lam);
#endif
    __syncthreads();
#ifndef NO_ATTA
    for (int rep = 0; rep < REP3A; ++rep)
    for (int st = vblk; st < BATCH * 2 * 4; st += gridDim.x) {
        const int q8 = st & 3, kvh = (st >> 2) & 1, b = st >> 3;
        attnA_strip(lds, proj, y, P.sink_a, b, kvh, 8 * q8, 8, negmA);
    }
#endif
}

#define XB_TMO      128
#define XB_XCNT(j)  (256  + 64 * (j))
#define XB_XSUB(j)  (1280 + 64 * (j))
#define XB_XGEN(j)  (2304 + 64 * (j))
#define XB_TOP      3328
#define XB_TOPGEN   3392
#define XCD_BAR_WORDS 3456
#define XB_SPIN_CAP (1u << 18)

__device__ __forceinline__ unsigned xb_ld(unsigned* p)              { return __hip_atomic_load(p, __ATOMIC_RELAXED, __HIP_MEMORY_SCOPE_AGENT); }
__device__ __forceinline__ unsigned xb_add(unsigned* p, unsigned v) { return __hip_atomic_fetch_add(p, v, __ATOMIC_RELAXED, __HIP_MEMORY_SCOPE_AGENT); }
__device__ __forceinline__ unsigned xb_xcc_id() { return (unsigned)__builtin_amdgcn_s_getreg((3 << 11) | 20) & 0xFu; }
#define XB_SPIN(cond, bar) do { unsigned _sp = 0; while (cond) { __builtin_amdgcn_s_sleep(1); \
    if ((++_sp & 255u) == 0u) { if (xb_ld(&(bar)[XB_TMO])) break; if (_sp > XB_SPIN_CAP) { atomicAdd(&(bar)[XB_TMO], 1u); break; } } } } while (0)

struct XcdBarrier {
    unsigned* bar; unsigned x;
    volatile LAS unsigned* st;
};

__device__ __forceinline__ XcdBarrier xcd_barrier_post(unsigned* bar, volatile LAS unsigned* st) {
    XcdBarrier b; b.bar = bar; b.x = xb_xcc_id(); b.st = st;
    if (threadIdx.x == 0) (void)xb_add(&bar[XB_XCNT(b.x)], 1u);
    return b;
}
__device__ __forceinline__ void xcd_barrier_complete(unsigned* bar, unsigned x, unsigned& nloc, unsigned& nx) {
    const unsigned G = gridDim.x * gridDim.y * gridDim.z;
    unsigned sum, cnt, mine, sp = 0u;
    for (;;) {
        sum = 0u; cnt = 0u; mine = 0u;
#pragma unroll
        for (unsigned j = 0; j < 16; ++j) { const unsigned c = xb_ld(&bar[XB_XCNT(j)]); sum += c; cnt += (c > 0u) ? 1u : 0u; mine = (j == x) ? c : mine; }
        if (sum == G) break;
        __builtin_amdgcn_s_sleep(1);
        if ((++sp & 255u) == 0u) { if (xb_ld(&bar[XB_TMO])) break; if (sp > XB_SPIN_CAP) { atomicAdd(&bar[XB_TMO], 1u); break; } }
    }
    nloc = mine > 0u ? mine : 1u; nx = cnt > 0u ? cnt : 1u;
}

__device__ __forceinline__ void xcd_barrier(const XcdBarrier& b) {
    asm volatile("s_waitcnt vmcnt(0)" ::: "memory");
    __syncthreads();
    if (threadIdx.x == 0) {
        unsigned* bar = b.bar;
        __builtin_amdgcn_s_waitcnt(0);
        unsigned nloc = b.st[0], nx = b.st[1];
        if (nloc == 0u) { xcd_barrier_complete(bar, b.x, nloc, nx); b.st[0] = nloc; b.st[1] = nx; }
        const unsigned old = xb_add(&bar[XB_XSUB(b.x)], 1u);
        const unsigned gen = old / nloc;
        if (old + 1u == (gen + 1u) * nloc) {
            __builtin_amdgcn_fence(__ATOMIC_RELEASE, "agent");
            asm volatile("s_waitcnt vmcnt(0)" ::: "memory");
            const unsigned og = xb_add(&bar[XB_TOP], 1u);
            const unsigned tg = og / nx;
            if (og + 1u == (tg + 1u) * nx) xb_add(&bar[XB_TOPGEN], 1u);
            else XB_SPIN(xb_ld(&bar[XB_TOPGEN]) == tg, bar);
            __builtin_amdgcn_fence(__ATOMIC_ACQUIRE, "agent");
            xb_add(&bar[XB_XGEN(b.x)], 1u);
            asm volatile("s_waitcnt vmcnt(0)" ::: "memory");
        } else {
            XB_SPIN(xb_ld(&bar[XB_XGEN(b.x)]) == gen, bar);
            __builtin_amdgcn_fence(__ATOMIC_ACQUIRE, "agent");
            asm volatile("s_waitcnt vmcnt(0)" ::: "memory");
        }
    }
    __syncthreads();
}

__global__ void __launch_bounds__(NTHREADS) hymba_fwd(Ptrs P) {
    extern __shared__ __attribute__((aligned(1024))) unsigned char lds_raw[];
    LAS unsigned char* lds = (LAS unsigned char*)lds_raw;
    cg::grid_group grid = cg::this_grid();
    const int lane = threadIdx.x & 63, wave = __builtin_amdgcn_readfirstlane(threadIdx.x >> 6);
    const int lo = P.ph_lo, hi = P.ph_hi;
    if (lo < 0) grid.sync();
    volatile LAS unsigned* bar_st = (volatile LAS unsigned*)(lds + 131072 + 1024);
    if (threadIdx.x < 2) bar_st[threadIdx.x] = 0u;
    __syncthreads();
    XcdBarrier bar = xcd_barrier_post((unsigned*)(P.ws + WS_CTL), bar_st);
#ifndef PHMASK
#define PHMASK 31
#endif
#define IN(k) (((PHMASK >> (k)) & 1) && lo <= (k) && (k) < hi)
#define SEAM(k) do { if (IN(k) && IN((k) + 1)) xcd_barrier(bar); } while (0)
    if (IN(0)) for (int rep = 0; rep < REP0; ++rep) phase0(P, lds, wave, lane);
    SEAM(0);
    if (IN(1)) for (int rep = 0; rep < REP1; ++rep) phase1(P, lds, wave, lane);
    SEAM(1);
    if (IN(2)) {
        __syncthreads();
        pg8::Gemm g{(const bf16_t*)(P.ws + WS_H), (const bf16_t*)(P.ws + WS_WIN), MROWS, 3328, 1024};
        pg8::StaticOrder S; S.init(MROWS, 3328, gridDim.x, (int)blockIdx.x, WGM_G1);
        pg8::EpiProj E{(bf16_t*)(P.ws + WS_PROJ), (const float*)(P.ws + WS_ROPE), P.q_norm_a, P.k_norm_a, P.q_norm_b, P.k_norm_b};
        pg8::gemm_phase<pg8::EpiProj, pg8::StaticOrder, true, true>(lds, g, S, E);
#if REP2 == 2
        __syncthreads();
        pg8::gemm_phase<pg8::EpiProj, pg8::StaticOrder, true, true>(lds, g, S, E);
#endif
    }
    SEAM(2);
    if (IN(3)) { __syncthreads(); phase3(P, lds); }
    SEAM(3);
    if (IN(4)) {
        __syncthreads();
        pg8::Gemm g{(const bf16_t*)(P.ws + WS_Y), (const bf16_t*)(P.ws + WS_WOUT), MROWS, 1024, 1024};
        pg8::StaticOrder S; S.init(MROWS, 1024, gridDim.x, (int)blockIdx.x, WGM_G2);
        pg8::EpiOut E{P.x, P.out, (const float*)(P.ws + WS_MOD) + 2048};
        pg8::gemm_phase<pg8::EpiOut, pg8::StaticOrder, true, true>(lds, g, S, E);
#if REP4 == 2
        __syncthreads();
        pg8::gemm_phase<pg8::EpiOut, pg8::StaticOrder, true, true>(lds, g, S, E);
#endif
    }
#undef IN
#undef SEAM
}

#ifndef MK_N_LAUNCHES
#define MK_N_LAUNCHES 1
#endif

extern "C" void kernel_launch(void* const* d_in, const int* in_sizes, int n_in, void* d_out, int out_size, void* d_ws, size_t ws_size, hipStream_t stream) {
    static int grid = 0;
    if (grid == 0) {
        if (n_in != 18 || ws_size < WS_END) { fprintf(stderr, "kernel_launch: unexpected n_in %d / ws_size %zu\n", n_in, ws_size); grid = -1; return; }
        int dev = 0, cus = 0, per_cu = 0;
        hipGetDevice(&dev);
        hipDeviceGetAttribute(&cus, hipDeviceAttributeMultiprocessorCount, dev);
        if (hipFuncSetAttribute((const void*)hymba_fwd, hipFuncAttributeMaxDynamicSharedMemorySize, LDS_BYTES) != hipSuccess) { fprintf(stderr, "kernel_launch: hipFuncSetAttribute failed\n"); grid = -1; return; }
        if (hipOccupancyMaxActiveBlocksPerMultiprocessor(&per_cu, (const void*)hymba_fwd, NTHREADS, LDS_BYTES) != hipSuccess || per_cu < 1) { fprintf(stderr, "kernel_launch: occupancy query says %d blocks/CU\n", per_cu); (void)hipGetLastError(); grid = -1; return; }
        grid = cus * per_cu;
        if (grid > 256) grid = 256;
    }
    if (grid < 0) return;
    if (hipMemsetAsync((char*)d_ws + WS_CTL, 0, CTL_BYTES, stream) != hipSuccess) { fprintf(stderr, "kernel_launch: memset of the barrier words failed\n"); return; }
    Ptrs p{};
    p.x = (const float*)d_in[0]; p.c = (const float*)d_in[1]; p.positions = (const int*)d_in[2]; p.w_ada = (const float*)d_in[3]; p.b_ada = (const float*)d_in[4];
    p.norm_gain = (const float*)d_in[5]; p.w_in = (const float*)d_in[6]; p.q_norm_a = (const float*)d_in[7]; p.k_norm_a = (const float*)d_in[8]; p.sink_a = (const float*)d_in[9];
    p.q_norm_b = (const float*)d_in[10]; p.k_norm_b = (const float*)d_in[11]; p.lq1 = (const float*)d_in[12]; p.lk1 = (const float*)d_in[13]; p.lq2 = (const float*)d_in[14];
    p.lk2 = (const float*)d_in[15]; p.subln = (const float*)d_in[16]; p.w_out = (const float*)d_in[17];
    p.out = (float*)d_out; p.ws = (unsigned char*)d_ws;
#if MK_N_LAUNCHES == 1
    p.ph_lo = 0; p.ph_hi = 5;
    void* args[] = {&p};
    hipError_t e = hipLaunchCooperativeKernel((const void*)hymba_fwd, dim3(grid), dim3(NTHREADS), args, LDS_BYTES, stream);
    if (e != hipSuccess) fprintf(stderr, "cooperative launch failed: %s (grid %d)\n", hipGetErrorString(e), grid);
#else
    for (int k = 0; k < 5; ++k) { p.ph_lo = k; p.ph_hi = k + 1; hipLaunchKernelGGL(hymba_fwd, dim3(grid), dim3(NTHREADS), LDS_BYTES, stream, p); }
#endif
}
```

```cpp
#include <hip/hip_runtime.h>
#include <hip/hip_cooperative_groups.h>
#include <cstdio>
#include <cstdint>
namespace cg = cooperative_groups;
#ifndef WGM_G1
#define WGM_G1 4
#endif
#ifndef WGM_G2
#define WGM_G2 4
#endif
#ifndef REP0
#define REP0 1
#endif
#ifndef REP1
#define REP1 1
#endif
#ifndef REP2
#define REP2 1
#endif
#ifndef REP3A
#define REP3A 1
#endif
#ifndef REP3B
#define REP3B 1
#endif
#ifndef REP4
#define REP4 1
#endif

namespace pg8 {
#define PG8_LAS __attribute__((address_space(3)))
typedef unsigned short bf16_t;
typedef short bf16x8 __attribute__((ext_vector_type(8)));
typedef float f32x4 __attribute__((ext_vector_type(4)));
typedef unsigned u32x4 __attribute__((ext_vector_type(4)));
constexpr int BM = 256, BK = 64, HALF = 128, HTB = HALF * BK * 2  , STAGE_BYTES = 8 * HTB, NXCD = 8;

__host__ __device__ __forceinline__ int lds_byte(int r, int c) { const int st = (r >> 4) * 2 + (c >> 5), rr = r & 15, cc = c & 31, ob = rr * 64 + cc * 2; return st * 1024 + (ob ^ (((ob >> 9) & 1) << 5)); }
__host__ __device__ __forceinline__ void stage_rc(int b, int& R, int& C) { const int st = b / 1024, sb = b % 1024, swz = sb ^ (((sb >> 9) & 1) << 5); R = (st >> 1) * 16 + swz / 64; C = (st & 1) * 32 + (swz % 64) / 2; }
__host__ __device__ __forceinline__ int perm32(int rho) { const int n = rho >> 4, i = rho & 15; return 8 * (i >> 2) + 4 * n + (i & 3); }

struct Unit { int pm, pn; };
struct Gemm { const bf16_t* A; const bf16_t* Bt; int M, N, K; };

struct StaticOrder {
    int nM, nN, nwg, G, c, WGM;
    __host__ __device__ void init(int M, int N, int G_, int c_, int wgm_ = 8) { nM = M / BM; nN = N / BM; nwg = nM * nN; G = G_; c = c_; WGM = wgm_; }
    __host__ __device__ bool next(int i, Unit& u) const {
        const long L = (long)i * G + c; if (L >= nwg) return false;
        int wgid = (int)L; { const int q = nwg / NXCD, r = nwg % NXCD, xcd = wgid % NXCD, off = wgid / NXCD; wgid = (xcd < r ? xcd * (q + 1) : r * (q + 1) + (xcd - r) * q) + off; }
        const int nig = WGM * nN, gid = wgid / nig, fm = gid * WGM, gsz = (nM - fm) < WGM ? (nM - fm) : WGM;
        u.pm = fm + ((wgid % nig) % gsz); u.pn = (wgid % nig) / gsz; return true;
    }
    __device__ __forceinline__ void a_ready(const Unit&) const {}
    __device__ __forceinline__ void done(const Unit&) const {}
};

typedef float f32x2 __attribute__((ext_vector_type(2)));
typedef __bf16 bf16x2_t __attribute__((ext_vector_type(2)));
__device__ __forceinline__ unsigned cvt_pk_bf16(float lo, float hi) { f32x2 v = {lo, hi}; bf16x2_t b = __builtin_convertvector(v, bf16x2_t); return __builtin_bit_cast(unsigned, b); }

constexpr int PROJ_W = 3328;
constexpr float QSCALE = 0.125f * 1.4426950408889634f;
constexpr float RMS_EPS = 1e-6f;

struct EpiProj {
    static constexpr bool PERM = true, AFTER_DRAIN = false;
    bf16_t* O; const float* rope; const float *gqa, *gka, *gqb, *gkb;
    __device__ __forceinline__ void operator()(const f32x4 (&acc)[2][2][4][2], const Unit& u, int wr, int wc, int fr, int fq) const {
        const int colh = u.pn * 256 + wc * 64;
        int mode; const float* gain = gqa; float osc = 1.f;
        if (colh < 512) { mode = 1; gain = gqa; osc = QSCALE; }
        else if (colh < 640) { mode = 1; gain = gka; }
        else if (colh < 768) mode = 0;
        else if (colh < 1280) mode = 2;
        else if (colh < 1792) { mode = 1; gain = gqb; osc = QSCALE; }
        else if (colh < 2304) { mode = 1; gain = gkb; }
        else if (colh < 2816) mode = 0;
        else mode = 2;
        const int row0 = u.pm * BM + wr * 64 + fr;
        if (mode == 1) {
            f32x4 g[2][2];
#pragma unroll
            for (int bj = 0; bj < 2; ++bj)
#pragma unroll
                for (int n = 0; n < 2; ++n) g[bj][n] = *(const f32x4*)(gain + 32 * bj + 8 * fq + 4 * n) * osc;
            f32x4 rc[4], rn[4];
#define ROPE_LOAD(dst, g_) do { const float* rp_ = rope + (size_t)(row0 + ((g_) >> 2) * HALF + ((g_) & 3) * 16) * 64 + 8 * fq; \
                dst[0] = *(const f32x4*)(rp_); dst[1] = *(const f32x4*)(rp_ + 4); dst[2] = *(const f32x4*)(rp_ + 32); dst[3] = *(const f32x4*)(rp_ + 36); } while (0)
            ROPE_LOAD(rc, 0);
#pragma unroll
            for (int gi = 0; gi < 8; ++gi) {
                const int ai = gi >> 2, m = gi & 3;
                if (gi < 7) ROPE_LOAD(rn, gi + 1);
                const int row = row0 + ai * HALF + m * 16;
                const f32x4 c0 = rc[0], c1 = rc[1], s0 = rc[2], s1 = rc[3];
                float ss = 0.f;
#pragma unroll
                for (int bj = 0; bj < 2; ++bj)
#pragma unroll
                    for (int n = 0; n < 2; ++n) { const f32x4 v = acc[ai][bj][m][n]; ss += (v[0] * v[0] + v[1] * v[1]) + (v[2] * v[2] + v[3] * v[3]); }
                ss += __shfl_xor(ss, 16); ss += __shfl_xor(ss, 32);
                const float rstd = rsqrtf(ss * (1.0f / 64.0f) + RMS_EPS);
                const f32x4 a0 = acc[ai][0][m][0] * rstd * g[0][0], a1 = acc[ai][0][m][1] * rstd * g[0][1];
                const f32x4 b0 = acc[ai][1][m][0] * rstd * g[1][0], b1 = acc[ai][1][m][1] * rstd * g[1][1];
                const f32x4 o00 = a0 * c0 - b0 * s0, o01 = a1 * c1 - b1 * s1, o10 = b0 * c0 + a0 * s0, o11 = b1 * c1 + a1 * s1;
                bf16_t* op = O + (size_t)row * PROJ_W + colh + 8 * fq;
                u32x4 w; w.x = cvt_pk_bf16(o00[0], o00[1]); w.y = cvt_pk_bf16(o00[2], o00[3]); w.z = cvt_pk_bf16(o01[0], o01[1]); w.w = cvt_pk_bf16(o01[2], o01[3]);
                *(u32x4*)op = w;
                w.x = cvt_pk_bf16(o10[0], o10[1]); w.y = cvt_pk_bf16(o10[2], o10[3]); w.z = cvt_pk_bf16(o11[0], o11[1]); w.w = cvt_pk_bf16(o11[2], o11[3]);
                *(u32x4*)(op + 32) = w;
#pragma unroll
                for (int k = 0; k < 4; ++k) rc[k] = rn[k];
            }
#undef ROPE_LOAD
        } else {
#pragma unroll
            for (int ai = 0; ai < 2; ++ai)
#pragma unroll
                for (int m = 0; m < 4; ++m) {
                    const int row = row0 + ai * HALF + m * 16;
                    bf16_t* op = O + (size_t)row * PROJ_W + colh + 8 * fq;
#pragma unroll
                    for (int bj = 0; bj < 2; ++bj) {
                        f32x4 v0 = acc[ai][bj][m][0], v1 = acc[ai][bj][m][1];
                        if (mode == 2) {
#pragma unroll
                            for (int j = 0; j < 4; ++j) { v0[j] = v0[j] * __builtin_amdgcn_rcpf(1.0f + __builtin_amdgcn_exp2f(-1.4426950408889634f * v0[j])); v1[j] = v1[j] * __builtin_amdgcn_rcpf(1.0f + __builtin_amdgcn_exp2f(-1.4426950408889634f * v1[j])); }
                        }
                        u32x4 w; w.x = cvt_pk_bf16(v0[0], v0[1]); w.y = cvt_pk_bf16(v0[2], v0[3]); w.z = cvt_pk_bf16(v1[0], v1[1]); w.w = cvt_pk_bf16(v1[2], v1[3]);
                        *(u32x4*)(op + 32 * bj) = w;
                    }
                }
        }
    }
};

struct EpiOut {
    static constexpr bool PERM = true, AFTER_DRAIN = false;
    const float* __restrict__ x; float* __restrict__ out; const float* __restrict__ gate;
    __device__ __forceinline__ void operator()(const f32x4 (&acc)[2][2][4][2], const Unit& u, int wr, int wc, int fr, int fq) const {
        const int row0 = u.pm * BM + wr * 64 + fr, col0 = u.pn * BM + wc * 32 + 8 * fq;
        const float* gp = gate + (size_t)(u.pm >> 3) * 3072 + col0;
        f32x4 gv[2][2];
#pragma unroll
        for (int bj = 0; bj < 2; ++bj)
#pragma unroll
            for (int n = 0; n < 2; ++n) gv[bj][n] = *(const f32x4*)(gp + bj * HALF + 4 * n);
        f32x4 xc[2][2][2], xn[2][2][2];
#define EPI_LOAD(dst, b) do { _Pragma("unroll") for (int mm = 0; mm < 2; ++mm) { const size_t off_ = (size_t)(row0 + ((b) >> 1) * HALF + (2 * ((b) & 1) + mm) * 16) * 1024 + col0; \
            _Pragma("unroll") for (int bj = 0; bj < 2; ++bj) _Pragma("unroll") for (int n = 0; n < 2; ++n) dst[mm][bj][n] = __builtin_nontemporal_load((const f32x4*)(x + off_ + bj * HALF + 4 * n)); } } while (0)
        EPI_LOAD(xc, 0);
#pragma unroll
        for (int b = 0; b < 4; ++b) {
            if (b < 3) EPI_LOAD(xn, b + 1);
#pragma unroll
            for (int mm = 0; mm < 2; ++mm) {
                const size_t off = (size_t)(row0 + (b >> 1) * HALF + (2 * (b & 1) + mm) * 16) * 1024 + col0;
#pragma unroll
                for (int bj = 0; bj < 2; ++bj)
#pragma unroll
                    for (int n = 0; n < 2; ++n) *(f32x4*)(out + off + bj * HALF + 4 * n) = xc[mm][bj][n] + gv[bj][n] * acc[b >> 1][bj][2 * (b & 1) + mm][n];
            }
#pragma unroll
            for (int mm = 0; mm < 2; ++mm)
#pragma unroll
                for (int bj = 0; bj < 2; ++bj)
#pragma unroll
                    for (int n = 0; n < 2; ++n) xc[mm][bj][n] = xn[mm][bj][n];
        }
#undef EPI_LOAD
    }
};

template <class Epi, class Sched, bool ALIGN_EPI = false, bool SP2 = false>
__device__ __forceinline__ void gemm_phase(PG8_LAS unsigned char* lds, const Gemm g, const Sched& S, const Epi& E) {
    const int tid = threadIdx.x, wid = __builtin_amdgcn_readfirstlane(tid >> 6), lane = tid & 63, wr = wid >> 2, wc = wid & 3, fr = lane & 15, fq = lane >> 4;
    const int K = g.K, nt = K / BK;
    unsigned voffA[2], voffB[2];
#pragma unroll
    for (int i = 0; i < 2; ++i) { int R, C; stage_rc(tid * 16 + i * 8192, R, C); const int Rb = Epi::PERM ? ((R & ~31) + perm32(R & 31)) : R;
        voffA[i] = (unsigned)(R * K + C) * 2u; voffB[i] = (unsigned)(Rb * K + C) * 2u; }
    const size_t kstep = (size_t)(BK * 2);
    const size_t hstep = (size_t)HALF * K * 2;
    const size_t tstep = 2 * hstep;
    const unsigned ldsw = (unsigned)wid * 1024u;
    const int aoff = lds_byte(wr * 64 + fr, fq * 8), boff = lds_byte(wc * 32 + fr, fq * 8);
#define PG8_SA(b, h) (((b) * 2 + (h)) * HTB)
#define PG8_SB(b, h) ((4 + (b) * 2 + (h)) * HTB)
#define PG8_STAGE(bufoff, gbase, voff) do { _Pragma("unroll") for (int _i = 0; _i < 2; ++_i) \
        __builtin_amdgcn_global_load_lds((const unsigned*)((const char*)(gbase) + (voff)[_i]), (PG8_LAS unsigned*)(lds + (bufoff) + ldsw + _i * 8192), 16, 0, 0); } while (0)
#define PG8_LDA(dst, b, h) do { _Pragma("unroll") for (int m = 0; m < 4; ++m) _Pragma("unroll") for (int k = 0; k < 2; ++k) dst[m][k] = *(const PG8_LAS bf16x8*)(lds + PG8_SA(b, h) + aoff + m * 2048 + k * 1024); } while (0)
#define PG8_LDB(dst, b, h) do { _Pragma("unroll") for (int n = 0; n < 2; ++n) _Pragma("unroll") for (int k = 0; k < 2; ++k) dst[n][k] = *(const PG8_LAS bf16x8*)(lds + PG8_SB(b, h) + boff + n * 2048 + k * 1024); } while (0)
#define PG8_MMA(ai, bj, At, Bt) do { __builtin_amdgcn_s_setprio(1); _Pragma("unroll") for (int m = 0; m < 4; ++m) _Pragma("unroll") for (int n = 0; n < 2; ++n) _Pragma("unroll") for (int k = 0; k < 2; ++k) \
        acc[ai][bj][m][n] = __builtin_amdgcn_mfma_f32_16x16x32_bf16(Bt[n][k], At[m][k], acc[ai][bj][m][n], 0, 0, 0); __builtin_amdgcn_s_setprio(0); } while (0)
#define PG8_WAIT_V(n) asm volatile("s_waitcnt vmcnt(" #n ")" ::: "memory")
#define PG8_WAIT_L(n) asm volatile("s_waitcnt lgkmcnt(" #n ")" ::: "memory")
#define PG8_BAR __builtin_amdgcn_s_barrier()
#define PG8_SCHED __builtin_amdgcn_sched_barrier(0)
    Unit cur, nxt; int ui = 0;
    if (!S.next(0, cur)) return;
    f32x4 acc[2][2][4][2];
#pragma unroll
    for (int a = 0; a < 2; ++a)
#pragma unroll
        for (int b = 0; b < 2; ++b)
#pragma unroll
            for (int m = 0; m < 4; ++m)
#pragma unroll
                for (int n = 0; n < 2; ++n) acc[a][b][m][n] = (f32x4){0.f, 0.f, 0.f, 0.f};
    bf16x8 At[4][2], B0[2][2], B1[2][2];
    const char* cA = (const char*)g.A + (size_t)cur.pm * tstep; const char* cB = (const char*)g.Bt + (size_t)cur.pn * tstep;
    S.a_ready(cur);
    if constexpr (SP2) {
        PG8_STAGE(PG8_SB(0, 0), cB, voffB); PG8_STAGE(PG8_SB(0, 1), cB + hstep, voffB); PG8_STAGE(PG8_SA(0, 0), cA, voffA); PG8_STAGE(PG8_SA(0, 1), cA + hstep, voffA);
        if (wr == 1) PG8_BAR;
        PG8_WAIT_V(2); PG8_BAR;
        PG8_STAGE(PG8_SB(1, 0), cB + kstep, voffB); PG8_STAGE(PG8_SA(1, 0), cA + kstep, voffA); PG8_STAGE(PG8_SB(1, 1), cB + hstep + kstep, voffB);
        PG8_WAIT_V(6); PG8_BAR;
    } else {
        PG8_STAGE(PG8_SB(0, 0), cB, voffB); PG8_STAGE(PG8_SA(0, 0), cA, voffA); PG8_STAGE(PG8_SB(0, 1), cB + hstep, voffB); PG8_STAGE(PG8_SA(0, 1), cA + hstep, voffA);
        if (wr == 1) PG8_BAR;
        PG8_WAIT_V(4); PG8_BAR;
        PG8_STAGE(PG8_SB(1, 0), cB + kstep, voffB); PG8_STAGE(PG8_SA(1, 0), cA + kstep, voffA); PG8_STAGE(PG8_SB(1, 1), cB + hstep + kstep, voffB);
        PG8_WAIT_V(6); PG8_BAR;
    }
    for (;;) {
        const bool has_next = S.next(ui + 1, nxt);
        const char* nA = has_next ? (const char*)g.A + (size_t)nxt.pm * tstep : cA; const char* nB = has_next ? (const char*)g.Bt + (size_t)nxt.pn * tstep : cB;
        for (int t = 0; t < nt; t += 2) {
            const bool last = (t == nt - 2);
            const char* a1 = cA + (size_t)(t + 1) * kstep;
            const char* a2 = last ? nA : cA + (size_t)(t + 2) * kstep; const char* b2 = last ? nB : cB + (size_t)(t + 2) * kstep;
            const char* a3 = a2 + kstep; const char* b3 = b2 + kstep;
            if (last && has_next) S.a_ready(nxt);
            if constexpr (SP2) {
            PG8_LDB(B0, 0, 0); PG8_LDB(B1, 0, 1); PG8_SCHED; PG8_LDA(At, 0, 0); PG8_STAGE(PG8_SA(1, 1), a1 + hstep, voffA);
            PG8_WAIT_V(8); PG8_WAIT_L(0); PG8_BAR; PG8_MMA(0, 0, At, B0); PG8_MMA(0, 1, At, B1); PG8_BAR; PG8_SCHED;
            PG8_LDA(At, 0, 1); PG8_STAGE(PG8_SB(0, 0), b2, voffB); PG8_STAGE(PG8_SB(0, 1), b2 + hstep, voffB); PG8_STAGE(PG8_SA(0, 0), a2, voffA);
            PG8_WAIT_V(8); PG8_WAIT_L(0); PG8_BAR; PG8_MMA(1, 0, At, B0); PG8_MMA(1, 1, At, B1); PG8_BAR; PG8_SCHED;
            PG8_LDB(B0, 1, 0); PG8_LDB(B1, 1, 1); PG8_SCHED; PG8_LDA(At, 1, 0); PG8_STAGE(PG8_SA(0, 1), a2 + hstep, voffA);
            PG8_WAIT_V(8); PG8_WAIT_L(0); PG8_BAR; PG8_MMA(0, 0, At, B0); PG8_MMA(0, 1, At, B1); PG8_BAR; PG8_SCHED;
            PG8_LDA(At, 1, 1); PG8_STAGE(PG8_SB(1, 0), b3, voffB); PG8_STAGE(PG8_SB(1, 1), b3 + hstep, voffB); PG8_STAGE(PG8_SA(1, 0), a3, voffA);
            PG8_WAIT_V(8); PG8_WAIT_L(0); PG8_BAR; PG8_MMA(1, 0, At, B0); PG8_MMA(1, 1, At, B1); PG8_BAR; PG8_SCHED;
            } else {
            PG8_LDB(B0, 0, 0); PG8_SCHED; PG8_LDA(At, 0, 0); PG8_STAGE(PG8_SA(1, 1), a1 + hstep, voffA);
            PG8_WAIT_L(8); PG8_BAR; PG8_WAIT_L(0); PG8_MMA(0, 0, At, B0); PG8_BAR; PG8_SCHED;
            PG8_LDB(B1, 0, 1); PG8_STAGE(PG8_SB(0, 0), b2, voffB);
            PG8_BAR; PG8_WAIT_L(0); PG8_MMA(0, 1, At, B1); PG8_BAR;
            PG8_LDA(At, 0, 1); PG8_STAGE(PG8_SA(0, 0), a2, voffA);
            PG8_BAR; PG8_WAIT_L(0); PG8_MMA(1, 0, At, B0); PG8_BAR; PG8_SCHED;
            PG8_STAGE(PG8_SB(0, 1), b2 + hstep, voffB);
            PG8_WAIT_V(6); PG8_BAR; PG8_MMA(1, 1, At, B1); PG8_BAR;
            PG8_LDB(B0, 1, 0); PG8_SCHED; PG8_LDA(At, 1, 0); PG8_STAGE(PG8_SA(0, 1), a2 + hstep, voffA);
            PG8_WAIT_L(8); PG8_BAR; PG8_WAIT_L(0); PG8_MMA(0, 0, At, B0); PG8_BAR; PG8_SCHED;
            PG8_LDB(B1, 1, 1); PG8_STAGE(PG8_SB(1, 0), b3, voffB);
            PG8_BAR; PG8_WAIT_L(0); PG8_MMA(0, 1, At, B1); PG8_BAR;
            PG8_LDA(At, 1, 1); PG8_STAGE(PG8_SA(1, 0), a3, voffA);
            PG8_BAR; PG8_WAIT_L(0); PG8_MMA(1, 0, At, B0); PG8_BAR; PG8_SCHED;
            PG8_STAGE(PG8_SB(1, 1), b3 + hstep, voffB);
            PG8_WAIT_V(6); PG8_BAR; PG8_MMA(1, 1, At, B1); PG8_BAR;
            }
        }
        if constexpr (ALIGN_EPI) { if (wr == 0) PG8_BAR; }
        if constexpr (!Epi::AFTER_DRAIN) { E(acc, cur, wr, wc, fr, fq); S.done(cur); }
        if (!has_next) break;
#pragma unroll
        for (int a = 0; a < 2; ++a)
#pragma unroll
            for (int b = 0; b < 2; ++b)
#pragma unroll
                for (int m = 0; m < 4; ++m)
#pragma unroll
                    for (int n = 0; n < 2; ++n) acc[a][b][m][n] = (f32x4){0.f, 0.f, 0.f, 0.f};
        cur = nxt; cA = nA; cB = nB; ++ui;
        if constexpr (ALIGN_EPI) { if (wr == 1) PG8_BAR; }
    }
    PG8_WAIT_V(0);
    if constexpr (!ALIGN_EPI) { if (wr == 0) PG8_BAR; }
    PG8_BAR;
    if constexpr (Epi::AFTER_DRAIN) { E.fused(acc, cur, wr, wc, fr, fq, lds, wid, lane); S.done(cur); }
#undef PG8_SA
#undef PG8_SB
#undef PG8_STAGE
#undef PG8_LDA
#undef PG8_LDB
#undef PG8_MMA
#undef PG8_WAIT_V
#undef PG8_WAIT_L
#undef PG8_BAR
#undef PG8_SCHED
}
}

constexpr int D_MODEL = 1024, BATCH = 32, SEQ = 2048, MROWS = BATCH * SEQ;
constexpr int NWAVES = 8, NTHREADS = 512;
constexpr float LOG2E = 1.4426950408889634f;
constexpr float RMS_EPS_ = 1e-6f;
constexpr float LAMBDA_INIT = 0.2f;
constexpr int C_QA = 0, C_KA = 512, C_VA = 640, C_GA = 768, C_QB = 1280, C_KB = 1792, C_VB = 2304, C_GB = 2816;

#define LAS __attribute__((address_space(3)))
typedef unsigned short bf16_t;
typedef short bf16x8 __attribute__((ext_vector_type(8)));
typedef short s16x4 __attribute__((ext_vector_type(4)));
typedef float f32x4 __attribute__((ext_vector_type(4)));
typedef float f32x16 __attribute__((ext_vector_type(16)));
typedef unsigned u32x4 __attribute__((ext_vector_type(4)));
typedef unsigned u32x2 __attribute__((ext_vector_type(2)));
using pg8::cvt_pk_bf16; using pg8::PROJ_W;

constexpr size_t MiB = 1u << 20;
constexpr size_t WS_MODP = 0;
constexpr size_t WS_CTL = 12 * MiB, CTL_BYTES = 16384;
constexpr size_t WS_MOD = 8 * MiB;
constexpr size_t WS_WIN = 16 * MiB;
constexpr size_t WS_WOUT = 24 * MiB;
constexpr size_t WS_ROPE = 32 * MiB;
constexpr size_t WS_H = 64 * MiB;
constexpr size_t WS_Y = WS_H;
constexpr size_t WS_PROJ = 192 * MiB;
constexpr size_t WS_END = WS_PROJ + (size_t)MROWS * 3328 * 2;

constexpr int LDS_BYTES = 147456;

__device__ __forceinline__ float wave_sum(float v) {
#pragma unroll
    for (int o = 1; o < 64; o <<= 1) v += __shfl_xor(v, o);
    return v;
}
__device__ __forceinline__ unsigned f2bf(float f) { unsigned u = __builtin_bit_cast(unsigned, f); return (u + 0x7fffu + ((u >> 16) & 1u)) >> 16; }
__device__ __forceinline__ unsigned pk2(float lo, float hi) { return cvt_pk_bf16(lo, hi); }
__device__ __forceinline__ float bf_lo(unsigned w) { return __builtin_bit_cast(float, w << 16); }
__device__ __forceinline__ float bf_hi(unsigned w) { return __builtin_bit_cast(float, w & 0xffff0000u); }

__device__ __forceinline__ void p0_transpose_item(const float* W, int K, int N, bf16_t* WT, bool headperm, LAS float* scr, int item, int lane) {
    const int nblk = N / 32, kb = item / nblk, nb = item % nblk, k0 = 64 * kb, n0 = 32 * nb;
    const int prow0 = headperm ? ((n0 & ~255) + 128 * ((n0 >> 5) & 1) + 32 * ((n0 >> 6) & 3)) : n0;
#pragma unroll 8
    for (int i = 0; i < 32; ++i) { const int kk = 2 * i + (lane >> 5); scr[kk * 33 + (lane & 31)] = W[(size_t)(k0 + kk) * N + n0 + (lane & 31)]; }
    __builtin_amdgcn_s_waitcnt(0xc07f); asm volatile("s_waitcnt lgkmcnt(0)" ::: "memory");
    const int c = lane & 7;
#pragma unroll
    for (int j = 0; j < 4; ++j) { const int n = (lane >> 3) + 8 * j; const LAS float* s = scr + (8 * c) * 33 + n;
        u32x4 o; o.x = pk2(s[0 * 33], s[1 * 33]); o.y = pk2(s[2 * 33], s[3 * 33]); o.z = pk2(s[4 * 33], s[5 * 33]); o.w = pk2(s[6 * 33], s[7 * 33]);
        *(u32x4*)(WT + (size_t)(prow0 + n) * K + k0 + 8 * c) = o; }
    asm volatile("s_waitcnt lgkmcnt(0)" ::: "memory");
}

__device__ __forceinline__ void p0_mod_item(const float* c, const float* w_ada, float* modp, LAS float* scr, int item, int lane) {
    const int kc = item / 48, cgp = item % 48, k0 = kc * 64, n = cgp * 64 + lane;
    float w[64];
#pragma unroll
    for (int k = 0; k < 64; ++k) w[k] = w_ada[(size_t)(k0 + k) * 3072 + n];
    {
        const int b = lane & 31, kh = lane >> 5;
#pragma unroll 8
        for (int kk = 0; kk < 32; ++kk) { const int k = 2 * kk + kh; const float v = c[b * 1024 + k0 + k]; scr[k * 32 + b] = v / (1.0f + __expf(-v)); }
    }
    asm volatile("s_waitcnt lgkmcnt(0)" ::: "memory");
    float acc[32];
#pragma unroll
    for (int b = 0; b < 32; ++b) acc[b] = 0.f;
#pragma unroll
    for (int k = 0; k < 64; ++k) {
#pragma unroll
        for (int b4 = 0; b4 < 8; ++b4) { const f32x4 sv = *(const LAS f32x4*)(scr + k * 32 + 4 * b4); acc[4 * b4] += sv[0] * w[k]; acc[4 * b4 + 1] += sv[1] * w[k]; acc[4 * b4 + 2] += sv[2] * w[k]; acc[4 * b4 + 3] += sv[3] * w[k]; }
    }
#pragma unroll
    for (int b = 0; b < 32; ++b) modp[((size_t)kc * 32 + b) * 3072 + n] = acc[b];
    asm volatile("s_waitcnt lgkmcnt(0)" ::: "memory");
}

__device__ __forceinline__ void p0_rope(const int* positions, float* rope, int idx, float inv_freq) {
    const int r = idx >> 5, i = idx & 31;
    const float angf = (float)positions[r] * inv_freq;
    const double a = (double)angf;
    const double nq = rint(a * 0.63661977236758134308);
    const double rr = (a - nq * 1.57079632679489655800) - nq * 6.12323399573676603587e-17;
    const double r2 = rr * rr;
    const double sn = rr * (1.0 + r2 * (-1.0 / 6 + r2 * (1.0 / 120 + r2 * (-1.0 / 5040 + r2 * (1.0 / 362880 + r2 * (-1.0 / 39916800 + r2 * (1.0 / 6227020800.0)))))));
    const double cs = 1.0 + r2 * (-0.5 + r2 * (1.0 / 24 + r2 * (-1.0 / 720 + r2 * (1.0 / 40320 + r2 * (-1.0 / 3628800 + r2 * (1.0 / 479001600 + r2 * (-1.0 / 87178291200.0)))))));
    const int q = ((int)(long long)nq) & 3;
    const double s = (q == 0) ? sn : (q == 1) ? cs : (q == 2) ? -sn : -cs;
    const double cc = (q == 0) ? cs : (q == 1) ? -sn : (q == 2) ? -cs : sn;
    rope[(size_t)r * 64 + i] = (float)cc; rope[(size_t)r * 64 + 32 + i] = (float)s;
}

struct Ptrs {
    const float *x, *c; const int* positions; const float *w_ada, *b_ada, *norm_gain, *w_in, *q_norm_a, *k_norm_a, *sink_a, *q_norm_b, *k_norm_b, *lq1, *lk1, *lq2, *lk2, *subln, *w_out;
    float* out; unsigned char* ws; int ph_lo, ph_hi;
};

__device__ __forceinline__ void phase0(const Ptrs& P, LAS unsigned char* lds, int wave, int lane) {
    LAS float* scr = (LAS float*)(lds + wave * 16384);
    const int gw = blockIdx.x * NWAVES + wave, NGW = gridDim.x * NWAVES;
    constexpr int I_MOD = 16 * 48, I_IN = (1024 / 64) * (3328 / 32), I_OUT = (1024 / 64) * (1024 / 32);
    constexpr int NITEMS = I_MOD + I_IN + I_OUT;
    float* modp = (float*)(P.ws + WS_MODP);
    const int nmodw = (NGW >= 2 * I_MOD) ? I_MOD : 0;
    if (gw < nmodw) p0_mod_item(P.c, P.w_ada, modp, scr, gw, lane);
    else {
        for (int it = gw - nmodw + (nmodw ? I_MOD : 0); it < NITEMS; it += NGW - nmodw) {
            int r = it;
            if (r < I_MOD) { p0_mod_item(P.c, P.w_ada, modp, scr, r, lane); continue; } r -= I_MOD;
            if (r < I_IN) { p0_transpose_item(P.w_in, 1024, 3328, (bf16_t*)(P.ws + WS_WIN), true, scr, r, lane); continue; } r -= I_IN;
            p0_transpose_item(P.w_out, 1024, 1024, (bf16_t*)(P.ws + WS_WOUT), false, scr, r, lane);
        }
    }
    float* rope = (float*)(P.ws + WS_ROPE);
    const float inv_freq = 1.0f / powf(10000.0f, (float)(2 * (threadIdx.x & 31)) / 64.0f);
    for (int idx = blockIdx.x * NTHREADS + threadIdx.x; idx < MROWS * 32; idx += gridDim.x * NTHREADS) p0_rope(P.positions, rope, idx, inv_freq);
}

__device__ __forceinline__ void phase1(const Ptrs& P, LAS unsigned char* lds, int wave, int lane) {
    LAS float* sh_gs = (LAS float*)lds;
    LAS float* sh_sf = (LAS float*)(lds + 4096);
    const float* modp = (const float*)(P.ws + WS_MODP);
    float* mod = (float*)(P.ws + WS_MOD);
    bf16_t* H = (bf16_t*)(P.ws + WS_H);
    for (int t = blockIdx.x; t < MROWS / 256; t += gridDim.x) {
        const int b = t >> 3;
        __syncthreads();
        for (int n = threadIdx.x; n < 3072; n += NTHREADS) {
            if (n >= 2048 && (t & 7) != 0) break;
            float s = P.b_ada[n];
#pragma unroll
            for (int kc = 0; kc < 16; ++kc) s += modp[((size_t)kc * 32 + b) * 3072 + n];
            if (n < 1024) sh_sf[n] = s;
            else if (n < 2048) sh_gs[n - 1024] = P.norm_gain[n - 1024] * (1.0f + s);
            else mod[(size_t)b * 3072 + n] = s;
        }
        __syncthreads();
        f32x4 v[4][4], vn[4][4];
        {
            const f32x4* xr = (const f32x4*)(P.x + ((size_t)t * 256 + wave * 32) * 1024) + lane;
#pragma unroll
            for (int q = 0; q < 4; ++q)
#pragma unroll
                for (int j = 0; j < 4; ++j) v[q][j] = __builtin_nontemporal_load(xr + q * 256 + 64 * j);
        }
        for (int rr = 0; rr < 32; rr += 4) {
            const size_t row = (size_t)t * 256 + wave * 32 + rr;
            if (rr + 4 < 32) {
                const f32x4* xr = (const f32x4*)(P.x + (row + 4) * 1024) + lane;
#pragma unroll
                for (int q = 0; q < 4; ++q)
#pragma unroll
                    for (int j = 0; j < 4; ++j) vn[q][j] = __builtin_nontemporal_load(xr + q * 256 + 64 * j);
            }
            float s[4];
#pragma unroll
            for (int q = 0; q < 4; ++q) { s[q] = 0.f;
#pragma unroll
                for (int j = 0; j < 4; ++j) s[q] += (v[q][j].x * v[q][j].x + v[q][j].y * v[q][j].y) + (v[q][j].z * v[q][j].z + v[q][j].w * v[q][j].w); }
#pragma unroll
            for (int o = 1; o < 64; o <<= 1) {
#pragma unroll
                for (int q = 0; q < 4; ++q) s[q] += __shfl_xor(s[q], o); }
#pragma unroll
            for (int q = 0; q < 4; ++q) {
                const float rstd = rsqrtf(s[q] * (1.f / 1024) + RMS_EPS_);
                u32x2* o8 = (u32x2*)(H + (row + q) * 1024) + lane;
#pragma unroll
                for (int j = 0; j < 4; ++j) {
                    const f32x4 g = *(const LAS f32x4*)(sh_gs + 256 * j + 4 * lane), sf = *(const LAS f32x4*)(sh_sf + 256 * j + 4 * lane);
                    const f32x4 hv = v[q][j] * rstd * g + sf;
                    u32x2 w; w.x = pk2(hv.x, hv.y); w.y = pk2(hv.z, hv.w); o8[64 * j] = w;
                }
            }
#pragma unroll
            for (int q = 0; q < 4; ++q)
#pragma unroll
                for (int j = 0; j < 4; ++j) v[q][j] = vn[q][j];
        }
    }
}

__device__ __forceinline__ unsigned off_b(unsigned row, unsigned ch) { return 256u * row + 16u * (ch ^ (((row & 3) << 2) | ((row >> 2) & 3))); }
__device__ __forceinline__ int crow(int r, int hi) { return (r & 3) + 8 * (r >> 2) + 4 * hi; }
__device__ __forceinline__ s16x4 vtr(const LAS unsigned char* p) { typedef short v4i16_t __attribute__((ext_vector_type(4))); return __builtin_bit_cast(s16x4, __builtin_amdgcn_ds_read_tr16_b64_v4i16((LAS v4i16_t*)p)); }
#define MFMA32(a, b, c) __builtin_amdgcn_mfma_f32_32x32x16_bf16((a), (b), (c), 0, 0, 0)

typedef const LAS unsigned char* ldsp_t;
__device__ __forceinline__ ldsp_t lxor(ldsp_t p, unsigned c) { return (ldsp_t)((unsigned)(uintptr_t)p ^ c); }
template <int NEB, bool MASK, bool QLDS, int KCH0, int VCH0, int QCH0>
__device__ __forceinline__ void att_half(ldsp_t kaddr, ldsp_t vaddr, ldsp_t qaddr, const bf16x8 (&qf)[4], f32x16 (&o)[NEB], float& l, float negm, int hi, int dq0  ) {
    f32x16 s;
#pragma unroll
    for (int i = 0; i < 16; ++i) s[i] = negm;
#pragma unroll
    for (int ks = 0; ks < 4; ++ks) {
        const bf16x8 kf = *(const LAS bf16x8*)lxor(kaddr, 16u * (KCH0 + 2 * ks));
        bf16x8 qv;
        if (QLDS) qv = *(const LAS bf16x8*)lxor(qaddr, 16u * (QCH0 + 2 * ks)); else qv = qf[ks];
        s = MFMA32(kf, qv, s);
    }
    float sum = 0.f;
#pragma unroll
    for (int i = 0; i < 16; ++i) {
        float p = __builtin_amdgcn_exp2f(s[i]);
        if (MASK) { const int d = dq0 - crow(i, hi); p = (d <= 128 && d >= -128) ? p : 0.f; }
        s[i] = p; sum += p;
    }
    l += sum;
    u32x4 w0, w1;
    w0.x = cvt_pk_bf16(s[0], s[1]); w0.y = cvt_pk_bf16(s[2], s[3]); w0.z = cvt_pk_bf16(s[4], s[5]); w0.w = cvt_pk_bf16(s[6], s[7]);
    w1.x = cvt_pk_bf16(s[8], s[9]); w1.y = cvt_pk_bf16(s[10], s[11]); w1.z = cvt_pk_bf16(s[12], s[13]); w1.w = cvt_pk_bf16(s[14], s[15]);
    const bf16x8 pk0 = __builtin_bit_cast(bf16x8, w0), pk1 = __builtin_bit_cast(bf16x8, w1);
#pragma unroll
    for (int eb = 0; eb < NEB; ++eb) {
        const ldsp_t a0 = lxor(vaddr, 64u * (VCH0 / 4 + eb)), a1 = lxor(vaddr, (64u * (VCH0 / 4 + eb)) ^ 32u);
#pragma unroll
        for (int u = 0; u < 2; ++u) {
            const s16x4 lo = vtr(a0 + 4096 * u);
            const s16x4 hh = vtr(a1 + 4096 * u + 2048);
            const bf16x8 vf = (bf16x8){lo[0], lo[1], lo[2], lo[3], hh[0], hh[1], hh[2], hh[3]};
            o[eb] = MFMA32(vf, u == 0 ? pk0 : pk1, o[eb]);
        }
    }
}
__device__ __forceinline__ unsigned lane_kL(int r32, int hi) { const unsigned xk = ((r32 & 3) << 2) | ((r32 >> 2) & 3); return 256u * r32 + 16u * ((unsigned)hi ^ xk); }
__device__ __forceinline__ unsigned lane_vL(int lane, int hi) { const unsigned blk = (lane >> 4) & 1, q = (lane & 15) >> 2, p = lane & 3; return 256u * (4 * hi + q) + 64u * q + ((32u * blk + 16u * (p >> 1)) ^ (16u * hi)) + 8u * (p & 1); }

__device__ __forceinline__ void glds16(const void* gsrc, unsigned lds_dst) { unsigned keep;
    asm volatile("s_mov_b32 %0, m0\n\ts_mov_b32 m0, %2\n\ts_nop 0\n\tglobal_load_lds_dwordx4 %1, off\n\ts_mov_b32 m0, %0" : "=&s"(keep) : "v"(gsrc), "s"(lds_dst) : "memory"); }
__device__ __forceinline__ f32x16 qk_half(ldsp_t kaddr, const bf16x8 (&qf)[4], float negm) {
    f32x16 s;
#pragma unroll
    for (int i = 0; i < 16; ++i) s[i] = negm;
#pragma unroll
    for (int ks = 0; ks < 4; ++ks) { const bf16x8 kf = *(const LAS bf16x8*)lxor(kaddr, 32u * ks); s = MFMA32(kf, qf[ks], s); }
    return s;
}
__device__ __forceinline__ void exp_pack(f32x16& s, float& l, bf16x8& pk0, bf16x8& pk1) {
    float sum = 0.f;
#pragma unroll
    for (int i = 0; i < 16; ++i) { s[i] = __builtin_amdgcn_exp2f(s[i]); sum += s[i]; }
    l += sum;
    u32x4 w0, w1;
    w0.x = cvt_pk_bf16(s[0], s[1]); w0.y = cvt_pk_bf16(s[2], s[3]); w0.z = cvt_pk_bf16(s[4], s[5]); w0.w = cvt_pk_bf16(s[6], s[7]);
    w1.x = cvt_pk_bf16(s[8], s[9]); w1.y = cvt_pk_bf16(s[10], s[11]); w1.z = cvt_pk_bf16(s[12], s[13]); w1.w = cvt_pk_bf16(s[14], s[15]);
    pk0 = __builtin_bit_cast(bf16x8, w0); pk1 = __builtin_bit_cast(bf16x8, w1);
}
template <int NEB, int VB = 0>
__device__ __forceinline__ void pv_half(ldsp_t vaddr, const bf16x8 pk0, const bf16x8 pk1, f32x16 (&o)[NEB]) {
#pragma unroll
    for (int eb = 0; eb < NEB; ++eb) {
        const ldsp_t a0 = lxor(vaddr, 64u * (VB + eb)), a1 = lxor(vaddr, (64u * (VB + eb)) ^ 32u);
#pragma unroll
        for (int u = 0; u < 2; ++u) {
            const s16x4 lo = vtr(a0 + 4096 * u);
            const s16x4 hh = vtr(a1 + 4096 * u + 2048);
            const bf16x8 vf = (bf16x8){lo[0], lo[1], lo[2], lo[3], hh[0], hh[1], hh[2], hh[3]};
            o[eb] = MFMA32(vf, u == 0 ? pk0 : pk1, o[eb]);
        }
    }
}

__device__ __forceinline__ void attnB_stream(LAS unsigned char* lds, const bf16_t* proj, bf16_t* y, const float* subln, int u0, int ustride, int nunits, float negm, float lam) {
    const int tid = threadIdx.x, lane = tid & 63, wid = __builtin_amdgcn_readfirstlane(tid >> 6), r32 = lane & 31, hi = lane >> 5;
    const int c = wid >> 2, rg = wid & 3;
    const int img = wid >> 2;
    unsigned goff[4];
#pragma unroll
    for (int i = 0; i < 4; ++i) goff[i] = (unsigned)((16 * (wid & 3) + 4 * i + (lane >> 4)) * PROJ_W + 8 * ((lane & 15) ^ (((lane >> 4) << 2) | i))) * 2u;
    const unsigned dst0 = img * 16384 + (4 * (wid & 3)) * 1024;
    const unsigned ldsbase = (unsigned)(uintptr_t)lds;
#define UNIT_GSRC(u) ((const char*)(proj + (size_t)((u) >> 6) * SEQ * PROJ_W + (img ? C_VB : C_KB) + 128 * (((u) >> 4) & 3)))
#define DMA_TILE(gs0, t, bufoff) do { const char* gs_ = (gs0) + (size_t)(t) * (64 * PROJ_W * 2); _Pragma("unroll") for (int i_ = 0; i_ < 4; ++i_) \
        glds16(gs_ + goff[i_], (unsigned)__builtin_amdgcn_readfirstlane(ldsbase + (bufoff) + dst0 + i_ * 1024)); } while (0)
#define LOAD_Q(u) do { const bf16_t* qp_ = proj + ((size_t)((u) >> 6) * SEQ + ((u) & 15) * 128 + rg * 32 + r32) * PROJ_W + C_QB + 128 * (((u) >> 4) & 3) + 64 * c + 8 * hi; \
        _Pragma("unroll") for (int s_ = 0; s_ < 4; ++s_) qf[s_] = *(const bf16x8*)(qp_ + 16 * s_); } while (0)
    LAS float* sh_gain = (LAS float*)(lds + 131072 + 2048);
    if (tid < 128) sh_gain[tid] = subln[tid];
    if (u0 >= nunits) return;
    int b0 = 0, b1 = 32768, b2 = 65536;
    bf16x8 qf[4];
    { const char* g0 = UNIT_GSRC(u0); DMA_TILE(g0, 0, b0); DMA_TILE(g0, 1, b1); LOAD_Q(u0); }
    unsigned kL = lane_kL(r32, hi) ^ (128u * c), vL = lane_vL(lane, hi);
    for (int u = u0; u < nunits; u += ustride) {
        const int un = u + ustride; const bool has_next = un < nunits;
        const char* gcur = UNIT_GSRC(u); const char* gnxt = UNIT_GSRC(has_next ? un : u);
        const int qb = u & 15, h = (u >> 4) & 3, b = u >> 6;
        const size_t qrow = (size_t)b * SEQ + qb * 128 + rg * 32 + r32;
        f32x16 o[4];
#pragma unroll
        for (int e = 0; e < 4; ++e)
#pragma unroll
            for (int i = 0; i < 16; ++i) o[e][i] = 0.f;
        float l = 0.f;
        if (u == u0) asm volatile("s_waitcnt vmcnt(0)" ::: "memory");
        __syncthreads();
#define SB_STAGE() __builtin_amdgcn_sched_barrier(0x2 | 0x4 | 0x400)
#define KLOAD(dst, base) do { _Pragma("unroll") for (int ks_ = 0; ks_ < 4; ++ks_) dst[ks_] = *(const LAS bf16x8*)lxor((base), 32u * ks_); } while (0)
#define VLOAD(dst, base, eb0) do { _Pragma("unroll") for (int e_ = 0; e_ < 2; ++e_) { const ldsp_t a0_ = lxor((base), 64u * ((eb0) + e_)), a1_ = lxor((base), (64u * ((eb0) + e_)) ^ 32u); \
            _Pragma("unroll") for (int u_ = 0; u_ < 2; ++u_) { const s16x4 lo_ = vtr(a0_ + 4096 * u_); const s16x4 hh_ = vtr(a1_ + 4096 * u_ + 2048); \
                dst[e_][u_] = (bf16x8){lo_[0], lo_[1], lo_[2], lo_[3], hh_[0], hh_[1], hh_[2], hh_[3]}; } } } while (0)
#define QKMMA(sd, kf) do { _Pragma("unroll") for (int ks_ = 0; ks_ < 4; ++ks_) sd = MFMA32(kf[ks_], qf[ks_], ks_ == 0 ? negv : sd); } while (0)
#define PVMMA(vf, eb0, p0, p1) do { _Pragma("unroll") for (int e_ = 0; e_ < 2; ++e_) { o[(eb0) + e_] = MFMA32(vf[e_][0], p0, o[(eb0) + e_]); o[(eb0) + e_] = MFMA32(vf[e_][1], p1, o[(eb0) + e_]); } } while (0)
        f32x16 negv;
#pragma unroll
        for (int i = 0; i < 16; ++i) negv[i] = negm;
        asm volatile("" : "+v"(negv));
        bf16x8 kfa[4], kfb[4], vfa[2][2], vfb[2][2], pa, pb, pc, pd;
        f32x16 s0, s1;
        KLOAD(kfa, lds + b0 + kL);
        KLOAD(kfb, lds + b0 + 8192 + kL);
        QKMMA(s0, kfa);
        for (int t = 0; t < 32; ++t) {
            asm volatile("" : "+v"(kL), "+v"(vL));
            if (t + 2 < 32) DMA_TILE(gcur, t + 2, b2); else if (has_next) DMA_TILE(gnxt, t - 30, b2);
            ldsp_t vb = lds + b0 + 16384 + vL, kn = lds + b1 + kL;
            VLOAD(vfa, vb, 0);
            QKMMA(s1, kfb);
            exp_pack(s0, l, pa, pb);
            SB_STAGE();
            VLOAD(vfb, vb, 2);
            PVMMA(vfa, 0, pa, pb);
            SB_STAGE();
            KLOAD(kfa, kn);
            PVMMA(vfb, 2, pa, pb);
            exp_pack(s1, l, pc, pd);
            SB_STAGE();
            VLOAD(vfa, vb + 8192, 0);
            QKMMA(s0, kfa);
            SB_STAGE();
            VLOAD(vfb, vb + 8192, 2);
            PVMMA(vfa, 0, pc, pd);
            SB_STAGE();
            KLOAD(kfb, kn + 8192);
            PVMMA(vfb, 2, pc, pd);
            asm volatile("s_waitcnt vmcnt(0)" ::: "memory");
            __syncthreads();
            const int tmp = b0; b0 = b1; b1 = b2; b2 = tmp;
        }
#undef SB_STAGE
#undef KLOAD
#undef VLOAD
#undef QKMMA
#undef PVMMA
        if (has_next) LOAD_Q(un);
        l += __shfl_xor(l, 32);
        LAS float* xch = (LAS float*)(lds + (rg < 2 ? b2 + rg * 16384 : 98304 + (rg - 2) * 16384)) + r32;
        const bf16_t* gp = proj + qrow * PROJ_W + C_GB + 128 * h + 8 * hi;
        if (c == 1) {
            const float i1 = lam / l;
#pragma unroll
            for (int e = 0; e < 4; ++e)
#pragma unroll
                for (int i = 0; i < 16; ++i) xch[(32 * e + crow(i, hi)) * 32] = o[e][i] * i1;
        }
        __syncthreads();
        if (c == 0) {
            u32x4 gc[2], gn2[2];
#pragma unroll
            for (int k = 0; k < 2; ++k) gc[k] = *(const u32x4*)(gp + 16 * k);
            const float i0 = 1.0f / l;
            float ss = 0.f;
#pragma unroll
            for (int e = 0; e < 4; ++e)
#pragma unroll
                for (int i = 0; i < 16; ++i) { const float v = o[e][i] * i0 - xch[(32 * e + crow(i, hi)) * 32]; o[e][i] = v; ss += v * v; }
            ss += __shfl_xor(ss, 32);
            const float rstd = rsqrtf(ss * (1.0f / 128.0f) + RMS_EPS_) * (1.0f - LAMBDA_INIT);
            bf16_t* yp16 = y + qrow * 1024 + 512 + 128 * h + 8 * hi;
#pragma unroll
            for (int e = 0; e < 4; ++e) {
                if (e < 3) {
#pragma unroll
                    for (int k = 0; k < 2; ++k) gn2[k] = *(const u32x4*)(gp + 32 * (e + 1) + 16 * k);
                }
#pragma unroll
                for (int k = 0; k < 2; ++k) {
                    float lo4[4], hi4[4];
#pragma unroll
                    for (int j = 0; j < 4; ++j) {
                        const auto r = __builtin_amdgcn_permlane32_swap(__float_as_uint(o[e][8 * k + j]), __float_as_uint(o[e][8 * k + 4 + j]), false, false);
                        lo4[j] = __uint_as_float(r[0]); hi4[j] = __uint_as_float(r[1]);
                    }
                    const f32x4 ga = *(const LAS f32x4*)(sh_gain + 32 * e + 16 * k + 8 * hi), gb = *(const LAS f32x4*)(sh_gain + 32 * e + 16 * k + 8 * hi + 4);
                    const u32x4 g4v = gc[k];
                    u32x4 w4;
                    w4.x = pk2(lo4[0] * rstd * ga[0] * bf_lo(g4v.x), lo4[1] * rstd * ga[1] * bf_hi(g4v.x)); w4.y = pk2(lo4[2] * rstd * ga[2] * bf_lo(g4v.y), lo4[3] * rstd * ga[3] * bf_hi(g4v.y));
                    w4.z = pk2(hi4[0] * rstd * gb[0] * bf_lo(g4v.z), hi4[1] * rstd * gb[1] * bf_hi(g4v.z)); w4.w = pk2(hi4[2] * rstd * gb[2] * bf_lo(g4v.w), hi4[3] * rstd * gb[3] * bf_hi(g4v.w));
                    *(u32x4*)(yp16 + 32 * e + 16 * k) = w4;
                }
#pragma unroll
                for (int k = 0; k < 2; ++k) gc[k] = gn2[k];
                asm volatile("" ::: "memory");
            }
        }
    }
#undef DMA_TILE
#undef UNIT_GSRC
#undef LOAD_Q
    __syncthreads();
}

__device__ __forceinline__ void attnA_strip(LAS unsigned char* lds, const bf16_t* proj, bf16_t* y, const float* sink, int b, int kvh, int qb0, int nq, float negm) {
    const int tid = threadIdx.x, lane = tid & 63, wid = __builtin_amdgcn_readfirstlane(tid >> 6), r32 = lane & 31, hi = lane >> 5;
    const size_t rowbase = (size_t)b * SEQ;
    const char* gsrc = (const char*)(proj + rowbase * PROJ_W);
    unsigned goff[2];
#pragma unroll
    for (int j = 0; j < 2; ++j) {
        const int blk = 2 * wid + j, row = 4 * blk + (lane >> 4);
        const int ch = (lane & 15) ^ (((lane >> 4) << 2) | (blk & 3));
        const int col = (ch < 8) ? (C_KA + 64 * kvh + 8 * ch) : (C_VA + 64 * kvh + 8 * (ch - 8));
        goff[j] = (unsigned)(row * PROJ_W + col) * 2u;
    }
    const unsigned ldsbase = (unsigned)(uintptr_t)lds;
#define DMA_TILE_A(kt) do { if ((kt) >= 0 && (kt) < 32) { const char* gs_ = gsrc + (size_t)(kt) * (64 * PROJ_W * 2); const unsigned so_ = ((kt) % 6) * 16384 + 2 * wid * 1024; \
        glds16(gs_ + goff[0], (unsigned)__builtin_amdgcn_readfirstlane(ldsbase + so_)); glds16(gs_ + goff[1], (unsigned)__builtin_amdgcn_readfirstlane(ldsbase + so_ + 1024)); } } while (0)
    for (int kt = qb0 - 2; kt <= qb0 + 2; ++kt) DMA_TILE_A(kt);
    const int g = wid & 3, rg = wid >> 2, head = 4 * kvh + g;
    const float sinkv = __builtin_amdgcn_exp2f(sink[head] * LOG2E + negm);
    unsigned kL = lane_kL(r32, hi), vL = lane_vL(lane, hi);
    bf16x8 qf[4];
    {
        const bf16_t* qp = proj + (rowbase + 64 * qb0 + 32 * rg + r32) * PROJ_W + C_QA + 64 * head + 8 * hi;
#pragma unroll
        for (int s = 0; s < 4; ++s) qf[s] = *(const bf16x8*)(qp + 16 * s);
    }
    for (int iq = 0; iq < nq; ++iq) {
        const int qb = qb0 + iq;
        const int qpos = 64 * qb + 32 * rg + r32;
        const size_t qrow = rowbase + qpos;
        f32x16 o[2];
#pragma unroll
        for (int e = 0; e < 2; ++e)
#pragma unroll
            for (int i = 0; i < 16; ++i) o[e][i] = 0.f;
        float l = 0.f;
        if (iq == 0) asm volatile("s_waitcnt vmcnt(0)" ::: "memory"); else asm volatile("s_waitcnt vmcnt(8)" ::: "memory");
        __syncthreads();
        if (iq + 1 < nq) DMA_TILE_A(qb + 3);
        const bf16_t* gp = proj + qrow * PROJ_W + C_GA + 64 * head + 8 * hi;
        u32x4 gt[2][2];
#pragma unroll
        for (int e = 0; e < 2; ++e)
#pragma unroll
            for (int k = 0; k < 2; ++k) gt[e][k] = *(const u32x4*)(gp + 32 * e + 16 * k);
        bf16x8 qn[4];
        {
            const bf16_t* qp = proj + (qrow + ((iq + 1 < nq) ? 64 : 0)) * PROJ_W + C_QA + 64 * head + 8 * hi;
#pragma unroll
            for (int s = 0; s < 4; ++s) qn[s] = *(const bf16x8*)(qp + 16 * s);
        }
        const int qw0 = 64 * qb + 32 * rg;
        const int i_lo = (qw0 - 128 < 0) ? ((128 - qw0) >> 5) : 0;
        const int i_hi = (qw0 + 128 > SEQ - 32) ? ((SEQ - 32 - qw0 + 128) >> 5) : 8;
#define HALF_IMG(i) (lds + (((qw0 - 128 + 32 * (i)) >> 6) % 6) * 16384 + (((qw0 - 128 + 32 * (i)) >> 5) & 1) * 8192)
#define KLOAD_A(dst, base) do { _Pragma("unroll") for (int ks_ = 0; ks_ < 4; ++ks_) dst[ks_] = *(const LAS bf16x8*)lxor((base), 32u * ks_); } while (0)
#define QK_A(sd, kf) do { _Pragma("unroll") for (int ks_ = 0; ks_ < 4; ++ks_) sd = MFMA32(kf[ks_], qf[ks_], ks_ == 0 ? negv : sd); } while (0)
        f32x16 negv;
#pragma unroll
        for (int r = 0; r < 16; ++r) negv[r] = negm;
        asm volatile("" : "+v"(negv));
        bf16x8 kfn[4], vf[2][2];
        f32x16 sc, sn;
#define A_STEP(MASKED) do { \
            asm volatile("" : "+v"(kL), "+v"(vL)); \
            const int n1_ = (i + 2 < i_hi) ? i + 2 : i_hi; \
            ldsp_t va_ = HALF_IMG(i) + vL; \
            _Pragma("unroll") for (int eb = 0; eb < 2; ++eb) { const ldsp_t a0 = lxor(va_, 64u * (2 + eb)), a1 = lxor(va_, (64u * (2 + eb)) ^ 32u); \
                _Pragma("unroll") for (int u = 0; u < 2; ++u) { const s16x4 lo = vtr(a0 + 4096 * u); const s16x4 hh = vtr(a1 + 4096 * u + 2048); vf[eb][u] = (bf16x8){lo[0], lo[1], lo[2], lo[3], hh[0], hh[1], hh[2], hh[3]}; } } \
            QK_A(sn, kfn); \
            __builtin_amdgcn_sched_barrier(0x2 | 0x4 | 0x400); \
            KLOAD_A(kfn, HALF_IMG(n1_) + kL); \
            _Pragma("unroll") for (int r = 0; r < 16; ++r) sc[r] = __builtin_amdgcn_exp2f(sc[r]); \
            if (MASKED) { const int dq0 = qpos - (qw0 - 128 + 32 * i); \
                _Pragma("unroll") for (int r = 0; r < 16; ++r) { const int d = dq0 - crow(r, hi); sc[r] = (d <= 128 && d >= -128) ? sc[r] : 0.f; } } \
            float sum = 0.f; \
            _Pragma("unroll") for (int r = 0; r < 16; ++r) sum += sc[r]; \
            l += sum; \
            u32x4 w0, w1; \
            w0.x = cvt_pk_bf16(sc[0], sc[1]); w0.y = cvt_pk_bf16(sc[2], sc[3]); w0.z = cvt_pk_bf16(sc[4], sc[5]); w0.w = cvt_pk_bf16(sc[6], sc[7]); \
            w1.x = cvt_pk_bf16(sc[8], sc[9]); w1.y = cvt_pk_bf16(sc[10], sc[11]); w1.z = cvt_pk_bf16(sc[12], sc[13]); w1.w = cvt_pk_bf16(sc[14], sc[15]); \
            const bf16x8 pk0 = __builtin_bit_cast(bf16x8, w0), pk1 = __builtin_bit_cast(bf16x8, w1); \
            _Pragma("unroll") for (int eb = 0; eb < 2; ++eb) { o[eb] = MFMA32(vf[eb][0], pk0, o[eb]); o[eb] = MFMA32(vf[eb][1], pk1, o[eb]); } \
            sc = sn; } while (0)
        KLOAD_A(kfn, HALF_IMG(i_lo) + kL);
        QK_A(sc, kfn);
        KLOAD_A(kfn, HALF_IMG((i_lo + 1 < i_hi) ? i_lo + 1 : i_hi) + kL);
        int i = i_lo;
        if (i == 0) { A_STEP(true); ++i; }
        const int i_end = (i_hi == 8) ? 7 : i_hi;
        for (; i <= i_end; ++i) A_STEP(false);
        if (i_hi == 8) A_STEP(true);
#undef A_STEP
#undef KLOAD_A
#undef QK_A
#undef HALF_IMG
        l += __shfl_xor(l, 32);
        l += sinkv;
        const float inv = 1.0f / l;
        bf16_t* yp16 = y + qrow * 1024 + 64 * head + 8 * hi;
#pragma unroll
        for (int e = 0; e < 2; ++e)
#pragma unroll
            for (int k = 0; k < 2; ++k) {
                float lo4[4], hi4[4];
#pragma unroll
                for (int j = 0; j < 4; ++j) {
                    const auto r = __builtin_amdgcn_permlane32_swap(__float_as_uint(o[e][8 * k + j]), __float_as_uint(o[e][8 * k + 4 + j]), false, false);
                    lo4[j] = __uint_as_float(r[0]); hi4[j] = __uint_as_float(r[1]);
                }
                const u32x4 g4v = gt[e][k];
                u32x4 w4;
                w4.x = pk2(lo4[0] * inv * bf_lo(g4v.x), lo4[1] * inv * bf_hi(g4v.x)); w4.y = pk2(lo4[2] * inv * bf_lo(g4v.y), lo4[3] * inv * bf_hi(g4v.y));
                w4.z = pk2(hi4[0] * inv * bf_lo(g4v.z), hi4[1] * inv * bf_hi(g4v.z)); w4.w = pk2(hi4[2] * inv * bf_lo(g4v.w), hi4[3] * inv * bf_hi(g4v.w));
                *(u32x4*)(yp16 + 32 * e + 16 * k) = w4;
            }
#pragma unroll
        for (int s = 0; s < 4; ++s) qf[s] = qn[s];
    }
#undef DMA_TILE_A
    __syncthreads();
}

__device__ __forceinline__ float absmax64(const float* g) { float m = 0.f; for (int i = 0; i < 64; ++i) m = fmaxf(m, fabsf(g[i])); return m; }

__device__ __forceinline__ void phase3(const Ptrs& P, LAS unsigned char* lds) {
    const bf16_t* proj = (const bf16_t*)(P.ws + WS_PROJ);
    bf16_t* y = (bf16_t*)(P.ws + WS_Y);
    const float negmA = -(8.0f * absmax64(P.q_norm_a) * absmax64(P.k_norm_a)) * LOG2E;
    const float negmB = -(8.0f * absmax64(P.q_norm_b) * absmax64(P.k_norm_b)) * LOG2E;
    float d1 = 0.f, d2 = 0.f;
    for (int i = 0; i < 64; ++i) { d1 += P.lq1[i] * P.lk1[i]; d2 += P.lq2[i] * P.lk2[i]; }
    const float lam = expf(d1) - expf(d2) + LAMBDA_INIT;
    const int vblk = ((gridDim.x & 7) == 0) ? (int)((blockIdx.x & 7) * (gridDim.x >> 3) + (blockIdx.x >> 3)) : (int)blockIdx.x;
#ifndef NO_ATTB
    for (int rep = 0; rep < REP3B; ++rep) attnB_stream(lds, proj, y, P.subln, vblk, (int)gridDim.x, BATCH * 4 * 16, negmB, lam);
#endif
    __syncthreads();
#ifndef NO_ATTA
    for (int rep = 0; rep < REP3A; ++rep)
    for (int st = vblk; st < BATCH * 2 * 4; st += gridDim.x) {
        const int q8 = st & 3, kvh = (st >> 2) & 1, b = st >> 3;
        attnA_strip(lds, proj, y, P.sink_a, b, kvh, 8 * q8, 8, negmA);
    }
#endif
}

#define XB_TMO      128
#define XB_XCNT(j)  (256  + 64 * (j))
#define XB_XSUB(j)  (1280 + 64 * (j))
#define XB_XGEN(j)  (2304 + 64 * (j))
#define XB_TOP      3328
#define XB_TOPGEN   3392
#define XCD_BAR_WORDS 3456
#define XB_SPIN_CAP (1u << 18)

__device__ __forceinline__ unsigned xb_ld(unsigned* p)              { return __hip_atomic_load(p, __ATOMIC_RELAXED, __HIP_MEMORY_SCOPE_AGENT); }
__device__ __forceinline__ unsigned xb_add(unsigned* p, unsigned v) { return __hip_atomic_fetch_add(p, v, __ATOMIC_RELAXED, __HIP_MEMORY_SCOPE_AGENT); }
__device__ __forceinline__ unsigned xb_xcc_id() { return (unsigned)__builtin_amdgcn_s_getreg((3 << 11) | 20) & 0xFu; }
#define XB_SPIN(cond, bar) do { unsigned _sp = 0; while (cond) { __builtin_amdgcn_s_sleep(1); \
    if ((++_sp & 255u) == 0u) { if (xb_ld(&(bar)[XB_TMO])) break; if (_sp > XB_SPIN_CAP) { atomicAdd(&(bar)[XB_TMO], 1u); break; } } } } while (0)

struct XcdBarrier {
    unsigned* bar; unsigned x;
    volatile LAS unsigned* st;
};

__device__ __forceinline__ XcdBarrier xcd_barrier_post(unsigned* bar, volatile LAS unsigned* st) {
    XcdBarrier b; b.bar = bar; b.x = xb_xcc_id(); b.st = st;
    if (threadIdx.x == 0) (void)xb_add(&bar[XB_XCNT(b.x)], 1u);
    return b;
}
__device__ __forceinline__ void xcd_barrier_complete(unsigned* bar, unsigned x, unsigned& nloc, unsigned& nx) {
    const unsigned G = gridDim.x * gridDim.y * gridDim.z;
    unsigned sum, cnt, mine, sp = 0u;
    for (;;) {
        sum = 0u; cnt = 0u; mine = 0u;
#pragma unroll
        for (unsigned j = 0; j < 16; ++j) { const unsigned c = xb_ld(&bar[XB_XCNT(j)]); sum += c; cnt += (c > 0u) ? 1u : 0u; mine = (j == x) ? c : mine; }
        if (sum == G) break;
        __builtin_amdgcn_s_sleep(1);
        if ((++sp & 255u) == 0u) { if (xb_ld(&bar[XB_TMO])) break; if (sp > XB_SPIN_CAP) { atomicAdd(&bar[XB_TMO], 1u); break; } }
    }
    nloc = mine > 0u ? mine : 1u; nx = cnt > 0u ? cnt : 1u;
}

__device__ __forceinline__ void xcd_barrier(const XcdBarrier& b) {
    asm volatile("s_waitcnt vmcnt(0)" ::: "memory");
    __syncthreads();
    if (threadIdx.x == 0) {
        unsigned* bar = b.bar;
        __builtin_amdgcn_s_waitcnt(0);
        unsigned nloc = b.st[0], nx = b.st[1];
        if (nloc == 0u) { xcd_barrier_complete(bar, b.x, nloc, nx); b.st[0] = nloc; b.st[1] = nx; }
        const unsigned old = xb_add(&bar[XB_XSUB(b.x)], 1u);
        const unsigned gen = old / nloc;
        if (old + 1u == (gen + 1u) * nloc) {
            __builtin_amdgcn_fence(__ATOMIC_RELEASE, "agent");
            asm volatile("s_waitcnt vmcnt(0)" ::: "memory");
            const unsigned og = xb_add(&bar[XB_TOP], 1u);
            const unsigned tg = og / nx;
            if (og + 1u == (tg + 1u) * nx) xb_add(&bar[XB_TOPGEN], 1u);
            else XB_SPIN(xb_ld(&bar[XB_TOPGEN]) == tg, bar);
            __builtin_amdgcn_fence(__ATOMIC_ACQUIRE, "agent");
            xb_add(&bar[XB_XGEN(b.x)], 1u);
            asm volatile("s_waitcnt vmcnt(0)" ::: "memory");
        } else {
            XB_SPIN(xb_ld(&bar[XB_XGEN(b.x)]) == gen, bar);
            __builtin_amdgcn_fence(__ATOMIC_ACQUIRE, "agent");
            asm volatile("s_waitcnt vmcnt(0)" ::: "memory");
        }
    }
    __syncthreads();
}

__global__ void __launch_bounds__(NTHREADS) hymba_fwd(Ptrs P) {
    extern __shared__ __attribute__((aligned(1024))) unsigned char lds_raw[];
    LAS unsigned char* lds = (LAS unsigned char*)lds_raw;
    cg::grid_group grid = cg::this_grid();
    const int lane = threadIdx.x & 63, wave = __builtin_amdgcn_readfirstlane(threadIdx.x >> 6);
    const int lo = P.ph_lo, hi = P.ph_hi;
    if (lo < 0) grid.sync();
    volatile LAS unsigned* bar_st = (volatile LAS unsigned*)(lds + 131072 + 1024);
    if (threadIdx.x < 2) bar_st[threadIdx.x] = 0u;
    __syncthreads();
    XcdBarrier bar = xcd_barrier_post((unsigned*)(P.ws + WS_CTL), bar_st);
#ifndef PHMASK
#define PHMASK 31
#endif
#define IN(k) (((PHMASK >> (k)) & 1) && lo <= (k) && (k) < hi)
#define SEAM(k) do { if (IN(k) && IN((k) + 1)) xcd_barrier(bar); } while (0)
    if (IN(0)) for (int rep = 0; rep < REP0; ++rep) phase0(P, lds, wave, lane);
    SEAM(0);
    if (IN(1)) for (int rep = 0; rep < REP1; ++rep) phase1(P, lds, wave, lane);
    SEAM(1);
    if (IN(2)) {
        __syncthreads();
        pg8::Gemm g{(const bf16_t*)(P.ws + WS_H), (const bf16_t*)(P.ws + WS_WIN), MROWS, 3328, 1024};
        pg8::StaticOrder S; S.init(MROWS, 3328, gridDim.x, (int)blockIdx.x, WGM_G1);
        pg8::EpiProj E{(bf16_t*)(P.ws + WS_PROJ), (const float*)(P.ws + WS_ROPE), P.q_norm_a, P.k_norm_a, P.q_norm_b, P.k_norm_b};
        pg8::gemm_phase<pg8::EpiProj, pg8::StaticOrder, true, true>(lds, g, S, E);
#if REP2 == 2
        __syncthreads();
        pg8::gemm_phase<pg8::EpiProj, pg8::StaticOrder, true, true>(lds, g, S, E);
#endif
    }
    SEAM(2);
    if (IN(3)) { __syncthreads(); phase3(P, lds); }
    SEAM(3);
    if (IN(4)) {
        __syncthreads();
        pg8::Gemm g{(const bf16_t*)(P.ws + WS_Y), (const bf16_t*)(P.ws + WS_WOUT), MROWS, 1024, 1024};
        pg8::StaticOrder S; S.init(MROWS, 1024, gridDim.x, (int)blockIdx.x, WGM_G2);
        pg8::EpiOut E{P.x, P.out, (const float*)(P.ws + WS_MOD) + 2048};
        pg8::gemm_phase<pg8::EpiOut, pg8::StaticOrder, true, true>(lds, g, S, E);
#if REP4 == 2
        __syncthreads();
        pg8::gemm_phase<pg8::EpiOut, pg8::StaticOrder, true, true>(lds, g, S, E);
#endif
    }
#undef IN
#undef SEAM
}

#ifndef MK_N_LAUNCHES
#define MK_N_LAUNCHES 1
#endif

extern "C" void kernel_launch(void* const* d_in, const int* in_sizes, int n_in, void* d_out, int out_size, void* d_ws, size_t ws_size, hipStream_t stream) {
    static int grid = 0;
    if (grid == 0) {
        if (n_in != 18 || ws_size < WS_END) { fprintf(stderr, "kernel_launch: unexpected n_in %d / ws_size %zu\n", n_in, ws_size); grid = -1; return; }
        int dev = 0, cus = 0, per_cu = 0;
        hipGetDevice(&dev);
        hipDeviceGetAttribute(&cus, hipDeviceAttributeMultiprocessorCount, dev);
        if (hipFuncSetAttribute((const void*)hymba_fwd, hipFuncAttributeMaxDynamicSharedMemorySize, LDS_BYTES) != hipSuccess) { fprintf(stderr, "kernel_launch: hipFuncSetAttribute failed\n"); grid = -1; return; }
        if (hipOccupancyMaxActiveBlocksPerMultiprocessor(&per_cu, (const void*)hymba_fwd, NTHREADS, LDS_BYTES) != hipSuccess || per_cu < 1) { fprintf(stderr, "kernel_launch: occupancy query says %d blocks/CU\n", per_cu); (void)hipGetLastError(); grid = -1; return; }
        grid = cus * per_cu;
        if (grid > 256) grid = 256;
    }
    if (grid < 0) return;
    if (hipMemsetAsync((char*)d_ws + WS_CTL, 0, CTL_BYTES, stream) != hipSuccess) { fprintf(stderr, "kernel_launch: memset of the barrier words failed\n"); return; }
    Ptrs p{};
    p.x = (const float*)d_in[0]; p.c = (const float*)d_in[1]; p.positions = (const int*)d_in[2]; p.w_ada = (const float*)d_in[3]; p.b_ada = (const float*)d_in[4];
    p.norm_gain = (const float*)d_in[5]; p.w_in = (const float*)d_in[6]; p.q_norm_a = (const float*)d_in[7]; p.k_norm_a = (const float*)d_in[8]; p.sink_a = (const float*)d_in[9];
    p.q_norm_b = (const float*)d_in[10]; p.k_norm_b = (const float*)d_in[11]; p.lq1 = (const float*)d_in[12]; p.lk1 = (const float*)d_in[13]; p.lq2 = (const float*)d_in[14];
    p.lk2 = (const float*)d_in[15]; p.subln = (const float*)d_in[16]; p.w_out = (const float*)d_in[17];
    p.out = (float*)d_out; p.ws = (unsigned char*)d_ws;
#if MK_N_LAUNCHES == 1
    p.ph_lo = 0; p.ph_hi = 5;
    void* args[] = {&p};
    hipError_t e = hipLaunchCooperativeKernel((const void*)hymba_fwd, dim3(grid), dim3(NTHREADS), args, LDS_BYTES, stream);
    if (e != hipSuccess) fprintf(stderr, "cooperative launch failed: %s (grid %d)\n", hipGetErrorString(e), grid);
#else
    for (int k = 0; k < 5; ++k) { p.ph_lo = k; p.ph_hi = k + 1; hipLaunchKernelGGL(hymba_fwd, dim3(grid), dim3(NTHREADS), LDS_BYTES, stream, p); }
#endif
}
```

```cpp
#include <hip/hip_runtime.h>
#include <hip/hip_cooperative_groups.h>
#include <cstdio>
#include <cstdint>
namespace cg = cooperative_groups;
#ifndef WGM_G1
#define WGM_G1 4
#endif
#ifndef WGM_G2
#define WGM_G2 4
#endif
#ifndef REP0
#define REP0 1
#endif
#ifndef REP1
#define REP1 1
#endif
#ifndef REP2
#define REP2 1
#endif
#ifndef REP3A
#define REP3A 1
#endif
#ifndef REP3B
#define REP3B 1
#endif
#ifndef REP4
#define REP4 1
#endif

namespace pg8 {
#define PG8_LAS __attribute__((address_space(3)))
typedef unsigned short bf16_t;
typedef short bf16x8 __attribute__((ext_vector_type(8)));
typedef float f32x4 __attribute__((ext_vector_type(4)));
typedef unsigned u32x4 __attribute__((ext_vector_type(4)));
constexpr int BM = 256, BK = 64, HALF = 128, HTB = HALF * BK * 2  , STAGE_BYTES = 8 * HTB, NXCD = 8;

__host__ __device__ __forceinline__ int lds_byte(int r, int c) { const int st = (r >> 4) * 2 + (c >> 5), rr = r & 15, cc = c & 31, ob = rr * 64 + cc * 2; return st * 1024 + (ob ^ (((ob >> 9) & 1) << 5)); }
__host__ __device__ __forceinline__ void stage_rc(int b, int& R, int& C) { const int st = b / 1024, sb = b % 1024, swz = sb ^ (((sb >> 9) & 1) << 5); R = (st >> 1) * 16 + swz / 64; C = (st & 1) * 32 + (swz % 64) / 2; }
__host__ __device__ __forceinline__ int perm32(int rho) { const int n = rho >> 4, i = rho & 15; return 8 * (i >> 2) + 4 * n + (i & 3); }

struct Unit { int pm, pn; };
struct Gemm { const bf16_t* A; const bf16_t* Bt; int M, N, K; };

struct StaticOrder {
    int nM, nN, nwg, G, c, WGM;
    __host__ __device__ void init(int M, int N, int G_, int c_, int wgm_ = 8) { nM = M / BM; nN = N / BM; nwg = nM * nN; G = G_; c = c_; WGM = wgm_; }
    __host__ __device__ bool next(int i, Unit& u) const {
        const long L = (long)i * G + c; if (L >= nwg) return false;
        int wgid = (int)L; { const int q = nwg / NXCD, r = nwg % NXCD, xcd = wgid % NXCD, off = wgid / NXCD; wgid = (xcd < r ? xcd * (q + 1) : r * (q + 1) + (xcd - r) * q) + off; }
        const int nig = WGM * nN, gid = wgid / nig, fm = gid * WGM, gsz = (nM - fm) < WGM ? (nM - fm) : WGM;
        u.pm = fm + ((wgid % nig) % gsz); u.pn = (wgid % nig) / gsz; return true;
    }
    __device__ __forceinline__ void a_ready(const Unit&) const {}
    __device__ __forceinline__ void done(const Unit&) const {}
};

typedef float f32x2 __attribute__((ext_vector_type(2)));
typedef __bf16 bf16x2_t __attribute__((ext_vector_type(2)));
__device__ __forceinline__ unsigned cvt_pk_bf16(float lo, float hi) { f32x2 v = {lo, hi}; bf16x2_t b = __builtin_convertvector(v, bf16x2_t); return __builtin_bit_cast(unsigned, b); }

constexpr int PROJ_W = 3328;
constexpr float QSCALE = 0.125f * 1.4426950408889634f;
constexpr float RMS_EPS = 1e-6f;

struct EpiProj {
    static constexpr bool PERM = true, AFTER_DRAIN = false;
    bf16_t* O; const float* rope; const float *gqa, *gka, *gqb, *gkb;
    __device__ __forceinline__ void operator()(const f32x4 (&acc)[2][2][4][2], const Unit& u, int wr, int wc, int fr, int fq) const {
        const int colh = u.pn * 256 + wc * 64;
        int mode; const float* gain = gqa; float osc = 1.f;
        if (colh < 512) { mode = 1; gain = gqa; osc = QSCALE; }
        else if (colh < 640) { mode = 1; gain = gka; }
        else if (colh < 768) mode = 0;
        else if (colh < 1280) mode = 2;
        else if (colh < 1792) { mode = 1; gain = gqb; osc = QSCALE; }
        else if (colh < 2304) { mode = 1; gain = gkb; }
        else if (colh < 2816) mode = 0;
        else mode = 2;
        const int row0 = u.pm * BM + wr * 64 + fr;
        if (mode == 1) {
            f32x4 g[2][2];
#pragma unroll
            for (int bj = 0; bj < 2; ++bj)
#pragma unroll
                for (int n = 0; n < 2; ++n) g[bj][n] = *(const f32x4*)(gain + 32 * bj + 8 * fq + 4 * n) * osc;
            f32x4 rc[4], rn[4];
#define ROPE_LOAD(dst, g_) do { const float* rp_ = rope + (size_t)(row0 + ((g_) >> 2) * HALF + ((g_) & 3) * 16) * 64 + 8 * fq; \
                dst[0] = *(const f32x4*)(rp_); dst[1] = *(const f32x4*)(rp_ + 4); dst[2] = *(const f32x4*)(rp_ + 32); dst[3] = *(const f32x4*)(rp_ + 36); } while (0)
            ROPE_LOAD(rc, 0);
#pragma unroll
            for (int gi = 0; gi < 8; ++gi) {
                const int ai = gi >> 2, m = gi & 3;
                if (gi < 7) ROPE_LOAD(rn, gi + 1);
                const int row = row0 + ai * HALF + m * 16;
                const f32x4 c0 = rc[0], c1 = rc[1], s0 = rc[2], s1 = rc[3];
                float ss = 0.f;
#pragma unroll
                for (int bj = 0; bj < 2; ++bj)
#pragma unroll
                    for (int n = 0; n < 2; ++n) { const f32x4 v = acc[ai][bj][m][n]; ss += (v[0] * v[0] + v[1] * v[1]) + (v[2] * v[2] + v[3] * v[3]); }
                ss += __shfl_xor(ss, 16); ss += __shfl_xor(ss, 32);
                const float rstd = rsqrtf(ss * (1.0f / 64.0f) + RMS_EPS);
                const f32x4 a0 = acc[ai][0][m][0] * rstd * g[0][0], a1 = acc[ai][0][m][1] * rstd * g[0][1];
                const f32x4 b0 = acc[ai][1][m][0] * rstd * g[1][0], b1 = acc[ai][1][m][1] * rstd * g[1][1];
                const f32x4 o00 = a0 * c0 - b0 * s0, o01 = a1 * c1 - b1 * s1, o10 = b0 * c0 + a0 * s0, o11 = b1 * c1 + a1 * s1;
                bf16_t* op = O + (size_t)row * PROJ_W + colh + 8 * fq;
                u32x4 w; w.x = cvt_pk_bf16(o00[0], o00[1]); w.y = cvt_pk_bf16(o00[2], o00[3]); w.z = cvt_pk_bf16(o01[0], o01[1]); w.w = cvt_pk_bf16(o01[2], o01[3]);
                *(u32x4*)op = w;
                w.x = cvt_pk_bf16(o10[0], o10[1]); w.y = cvt_pk_bf16(o10[2], o10[3]); w.z = cvt_pk_bf16(o11[0], o11[1]); w.w = cvt_pk_bf16(o11[2], o11[3]);
                *(u32x4*)(op + 32) = w;
#pragma unroll
                for (int k = 0; k < 4; ++k) rc[k] = rn[k];
            }
#undef ROPE_LOAD
        } else if (mode == 2) {
#pragma unroll
            for (int ai = 0; ai < 2; ++ai)
#pragma unroll
                for (int m = 0; m < 4; ++m) {
                    const int row = row0 + ai * HALF + m * 16;
                    bf16_t* op = O + (size_t)row * PROJ_W + colh + 8 * fq;
#pragma unroll
                    for (int bj = 0; bj < 2; ++bj) {
                        f32x4 v0 = acc[ai][bj][m][0], v1 = acc[ai][bj][m][1];
#pragma unroll
                        for (int j = 0; j < 4; ++j) { v0[j] = v0[j] * __builtin_amdgcn_rcpf(1.0f + __builtin_amdgcn_exp2f(-1.4426950408889634f * v0[j])); v1[j] = v1[j] * __builtin_amdgcn_rcpf(1.0f + __builtin_amdgcn_exp2f(-1.4426950408889634f * v1[j])); }
                        u32x4 w; w.x = cvt_pk_bf16(v0[0], v0[1]); w.y = cvt_pk_bf16(v0[2], v0[3]); w.z = cvt_pk_bf16(v1[0], v1[1]); w.w = cvt_pk_bf16(v1[2], v1[3]);
                        *(u32x4*)(op + 32 * bj) = w;
                    }
                }
        } else {
#pragma unroll
            for (int ai = 0; ai < 2; ++ai)
#pragma unroll
                for (int m = 0; m < 4; ++m) {
                    const int row = row0 + ai * HALF + m * 16;
                    bf16_t* op = O + (size_t)row * PROJ_W + colh + 8 * fq;
#pragma unroll
                    for (int bj = 0; bj < 2; ++bj) {
                        const f32x4 v0 = acc[ai][bj][m][0], v1 = acc[ai][bj][m][1];
                        u32x4 w; w.x = cvt_pk_bf16(v0[0], v0[1]); w.y = cvt_pk_bf16(v0[2], v0[3]); w.z = cvt_pk_bf16(v1[0], v1[1]); w.w = cvt_pk_bf16(v1[2], v1[3]);
                        *(u32x4*)(op + 32 * bj) = w;
                    }
                }
        }
    }
};

struct EpiOut {
    static constexpr bool PERM = true, AFTER_DRAIN = false;
    const float* __restrict__ x; float* __restrict__ out; const float* __restrict__ gate;
    __device__ __forceinline__ void operator()(const f32x4 (&acc)[2][2][4][2], const Unit& u, int wr, int wc, int fr, int fq) const {
        const int row0 = u.pm * BM + wr * 64 + fr, col0 = u.pn * BM + wc * 32 + 8 * fq;
        const float* gp = gate + (size_t)(u.pm >> 3) * 3072 + col0;
        f32x4 gv[2][2];
#pragma unroll
        for (int bj = 0; bj < 2; ++bj)
#pragma unroll
            for (int n = 0; n < 2; ++n) gv[bj][n] = *(const f32x4*)(gp + bj * HALF + 4 * n);
        f32x4 xc[2][2][2], xn[2][2][2];
#define EPI_LOAD(dst, b) do { _Pragma("unroll") for (int mm = 0; mm < 2; ++mm) { const size_t off_ = (size_t)(row0 + ((b) >> 1) * HALF + (2 * ((b) & 1) + mm) * 16) * 1024 + col0; \
            _Pragma("unroll") for (int bj = 0; bj < 2; ++bj) _Pragma("unroll") for (int n = 0; n < 2; ++n) dst[mm][bj][n] = __builtin_nontemporal_load((const f32x4*)(x + off_ + bj * HALF + 4 * n)); } } while (0)
        EPI_LOAD(xc, 0);
#pragma unroll
        for (int b = 0; b < 4; ++b) {
            if (b < 3) EPI_LOAD(xn, b + 1);
#pragma unroll
            for (int mm = 0; mm < 2; ++mm) {
                const size_t off = (size_t)(row0 + (b >> 1) * HALF + (2 * (b & 1) + mm) * 16) * 1024 + col0;
#pragma unroll
                for (int bj = 0; bj < 2; ++bj)
#pragma unroll
                    for (int n = 0; n < 2; ++n) *(f32x4*)(out + off + bj * HALF + 4 * n) = xc[mm][bj][n] + gv[bj][n] * acc[b >> 1][bj][2 * (b & 1) + mm][n];
            }
#pragma unroll
            for (int mm = 0; mm < 2; ++mm)
#pragma unroll
                for (int bj = 0; bj < 2; ++bj)
#pragma unroll
                    for (int n = 0; n < 2; ++n) xc[mm][bj][n] = xn[mm][bj][n];
        }
#undef EPI_LOAD
    }
};

template <class Epi, class Sched, bool ALIGN_EPI = false, bool SP2 = false>
__device__ __forceinline__ void gemm_phase(PG8_LAS unsigned char* lds, const Gemm g, const Sched& S, const Epi& E) {
    const int tid = threadIdx.x, wid = __builtin_amdgcn_readfirstlane(tid >> 6), lane = tid & 63, wr = wid >> 2, wc = wid & 3, fr = lane & 15, fq = lane >> 4;
    const int K = g.K, nt = K / BK;
    unsigned voffA[2], voffB[2];
#pragma unroll
    for (int i = 0; i < 2; ++i) { int R, C; stage_rc(tid * 16 + i * 8192, R, C); const int Rb = Epi::PERM ? ((R & ~31) + perm32(R & 31)) : R;
        voffA[i] = (unsigned)(R * K + C) * 2u; voffB[i] = (unsigned)(Rb * K + C) * 2u; }
    const size_t kstep = (size_t)(BK * 2);
    const size_t hstep = (size_t)HALF * K * 2;
    const size_t tstep = 2 * hstep;
    const unsigned ldsw = (unsigned)wid * 1024u;
    const int aoff = lds_byte(wr * 64 + fr, fq * 8), boff = lds_byte(wc * 32 + fr, fq * 8);
#define PG8_SA(b, h) (((b) * 2 + (h)) * HTB)
#define PG8_SB(b, h) ((4 + (b) * 2 + (h)) * HTB)
#define PG8_STAGE(bufoff, gbase, voff) do { _Pragma("unroll") for (int _i = 0; _i < 2; ++_i) \
        __builtin_amdgcn_global_load_lds((const unsigned*)((const char*)(gbase) + (voff)[_i]), (PG8_LAS unsigned*)(lds + (bufoff) + ldsw + _i * 8192), 16, 0, 0); } while (0)
#define PG8_LDA(dst, b, h) do { _Pragma("unroll") for (int m = 0; m < 4; ++m) _Pragma("unroll") for (int k = 0; k < 2; ++k) dst[m][k] = *(const PG8_LAS bf16x8*)(lds + PG8_SA(b, h) + aoff + m * 2048 + k * 1024); } while (0)
#define PG8_LDB(dst, b, h) do { _Pragma("unroll") for (int n = 0; n < 2; ++n) _Pragma("unroll") for (int k = 0; k < 2; ++k) dst[n][k] = *(const PG8_LAS bf16x8*)(lds + PG8_SB(b, h) + boff + n * 2048 + k * 1024); } while (0)
#define PG8_MMA(ai, bj, At, Bt) do { __builtin_amdgcn_s_setprio(1); _Pragma("unroll") for (int m = 0; m < 4; ++m) _Pragma("unroll") for (int n = 0; n < 2; ++n) _Pragma("unroll") for (int k = 0; k < 2; ++k) \
        acc[ai][bj][m][n] = __builtin_amdgcn_mfma_f32_16x16x32_bf16(Bt[n][k], At[m][k], acc[ai][bj][m][n], 0, 0, 0); __builtin_amdgcn_s_setprio(0); } while (0)
#define PG8_WAIT_V(n) asm volatile("s_waitcnt vmcnt(" #n ")" ::: "memory")
#define PG8_WAIT_L(n) asm volatile("s_waitcnt lgkmcnt(" #n ")" ::: "memory")
#define PG8_BAR __builtin_amdgcn_s_barrier()
#define PG8_SCHED __builtin_amdgcn_sched_barrier(0)
    Unit cur, nxt; int ui = 0;
    if (!S.next(0, cur)) return;
    f32x4 acc[2][2][4][2];
#pragma unroll
    for (int a = 0; a < 2; ++a)
#pragma unroll
        for (int b = 0; b < 2; ++b)
#pragma unroll
            for (int m = 0; m < 4; ++m)
#pragma unroll
                for (int n = 0; n < 2; ++n) acc[a][b][m][n] = (f32x4){0.f, 0.f, 0.f, 0.f};
    bf16x8 At[4][2], B0[2][2], B1[2][2];
    const char* cA = (const char*)g.A + (size_t)cur.pm * tstep; const char* cB = (const char*)g.Bt + (size_t)cur.pn * tstep;
    S.a_ready(cur);
    if constexpr (SP2) {
        PG8_STAGE(PG8_SB(0, 0), cB, voffB); PG8_STAGE(PG8_SB(0, 1), cB + hstep, voffB); PG8_STAGE(PG8_SA(0, 0), cA, voffA); PG8_STAGE(PG8_SA(0, 1), cA + hstep, voffA);
        if (wr == 1) PG8_BAR;
        PG8_WAIT_V(2); PG8_BAR;
        PG8_STAGE(PG8_SB(1, 0), cB + kstep, voffB); PG8_STAGE(PG8_SA(1, 0), cA + kstep, voffA); PG8_STAGE(PG8_SB(1, 1), cB + hstep + kstep, voffB);
        PG8_WAIT_V(6); PG8_BAR;
    } else {
        PG8_STAGE(PG8_SB(0, 0), cB, voffB); PG8_STAGE(PG8_SA(0, 0), cA, voffA); PG8_STAGE(PG8_SB(0, 1), cB + hstep, voffB); PG8_STAGE(PG8_SA(0, 1), cA + hstep, voffA);
        if (wr == 1) PG8_BAR;
        PG8_WAIT_V(4); PG8_BAR;
        PG8_STAGE(PG8_SB(1, 0), cB + kstep, voffB); PG8_STAGE(PG8_SA(1, 0), cA + kstep, voffA); PG8_STAGE(PG8_SB(1, 1), cB + hstep + kstep, voffB);
        PG8_WAIT_V(6); PG8_BAR;
    }
    for (;;) {
        const bool has_next = S.next(ui + 1, nxt);
        const char* nA = has_next ? (const char*)g.A + (size_t)nxt.pm * tstep : cA; const char* nB = has_next ? (const char*)g.Bt + (size_t)nxt.pn * tstep : cB;
        for (int t = 0; t < nt; t += 2) {
            const bool last = (t == nt - 2);
            const char* a1 = cA + (size_t)(t + 1) * kstep;
            const char* a2 = last ? nA : cA + (size_t)(t + 2) * kstep; const char* b2 = last ? nB : cB + (size_t)(t + 2) * kstep;
            const char* a3 = a2 + kstep; const char* b3 = b2 + kstep;
            if (last && has_next) S.a_ready(nxt);
            if constexpr (SP2) {
            PG8_LDB(B0, 0, 0); PG8_LDB(B1, 0, 1); PG8_SCHED; PG8_LDA(At, 0, 0); PG8_STAGE(PG8_SA(1, 1), a1 + hstep, voffA);
            PG8_WAIT_V(8); PG8_WAIT_L(0); PG8_BAR; PG8_MMA(0, 0, At, B0); PG8_MMA(0, 1, At, B1); PG8_BAR; PG8_SCHED;
            PG8_LDA(At, 0, 1); PG8_STAGE(PG8_SB(0, 0), b2, voffB); PG8_STAGE(PG8_SB(0, 1), b2 + hstep, voffB); PG8_STAGE(PG8_SA(0, 0), a2, voffA);
            PG8_WAIT_V(8); PG8_WAIT_L(0); PG8_BAR; PG8_MMA(1, 0, At, B0); PG8_MMA(1, 1, At, B1); PG8_BAR; PG8_SCHED;
            PG8_LDB(B0, 1, 0); PG8_LDB(B1, 1, 1); PG8_SCHED; PG8_LDA(At, 1, 0); PG8_STAGE(PG8_SA(0, 1), a2 + hstep, voffA);
            PG8_WAIT_V(8); PG8_WAIT_L(0); PG8_BAR; PG8_MMA(0, 0, At, B0); PG8_MMA(0, 1, At, B1); PG8_BAR; PG8_SCHED;
            PG8_LDA(At, 1, 1); PG8_STAGE(PG8_SB(1, 0), b3, voffB); PG8_STAGE(PG8_SB(1, 1), b3 + hstep, voffB); PG8_STAGE(PG8_SA(1, 0), a3, voffA);
            PG8_WAIT_V(8); PG8_WAIT_L(0); PG8_BAR; PG8_MMA(1, 0, At, B0); PG8_MMA(1, 1, At, B1); PG8_BAR; PG8_SCHED;
            } else {
            PG8_LDB(B0, 0, 0); PG8_SCHED; PG8_LDA(At, 0, 0); PG8_STAGE(PG8_SA(1, 1), a1 + hstep, voffA);
            PG8_WAIT_L(8); PG8_BAR; PG8_WAIT_L(0); PG8_MMA(0, 0, At, B0); PG8_BAR; PG8_SCHED;
            PG8_LDB(B1, 0, 1); PG8_STAGE(PG8_SB(0, 0), b2, voffB);
            PG8_BAR; PG8_WAIT_L(0); PG8_MMA(0, 1, At, B1); PG8_BAR;
            PG8_LDA(At, 0, 1); PG8_STAGE(PG8_SA(0, 0), a2, voffA);
            PG8_BAR; PG8_WAIT_L(0); PG8_MMA(1, 0, At, B0); PG8_BAR; PG8_SCHED;
            PG8_STAGE(PG8_SB(0, 1), b2 + hstep, voffB);
            PG8_WAIT_V(6); PG8_BAR; PG8_MMA(1, 1, At, B1); PG8_BAR;
            PG8_LDB(B0, 1, 0); PG8_SCHED; PG8_LDA(At, 1, 0); PG8_STAGE(PG8_SA(0, 1), a2 + hstep, voffA);
            PG8_WAIT_L(8); PG8_BAR; PG8_WAIT_L(0); PG8_MMA(0, 0, At, B0); PG8_BAR; PG8_SCHED;
            PG8_LDB(B1, 1, 1); PG8_STAGE(PG8_SB(1, 0), b3, voffB);
            PG8_BAR; PG8_WAIT_L(0); PG8_MMA(0, 1, At, B1); PG8_BAR;
            PG8_LDA(At, 1, 1); PG8_STAGE(PG8_SA(1, 0), a3, voffA);
            PG8_BAR; PG8_WAIT_L(0); PG8_MMA(1, 0, At, B0); PG8_BAR; PG8_SCHED;
            PG8_STAGE(PG8_SB(1, 1), b3 + hstep, voffB);
            PG8_WAIT_V(6); PG8_BAR; PG8_MMA(1, 1, At, B1); PG8_BAR;
            }
        }
        if constexpr (ALIGN_EPI) { if (wr == 0) PG8_BAR; }
        if constexpr (!Epi::AFTER_DRAIN) { E(acc, cur, wr, wc, fr, fq); S.done(cur); }
        if (!has_next) break;
#pragma unroll
        for (int a = 0; a < 2; ++a)
#pragma unroll
            for (int b = 0; b < 2; ++b)
#pragma unroll
                for (int m = 0; m < 4; ++m)
#pragma unroll
                    for (int n = 0; n < 2; ++n) acc[a][b][m][n] = (f32x4){0.f, 0.f, 0.f, 0.f};
        cur = nxt; cA = nA; cB = nB; ++ui;
        if constexpr (ALIGN_EPI) { if (wr == 1) PG8_BAR; }
    }
    PG8_WAIT_V(0);
    if constexpr (!ALIGN_EPI) { if (wr == 0) PG8_BAR; }
    PG8_BAR;
    if constexpr (Epi::AFTER_DRAIN) { E.fused(acc, cur, wr, wc, fr, fq, lds, wid, lane); S.done(cur); }
#undef PG8_SA
#undef PG8_SB
#undef PG8_STAGE
#undef PG8_LDA
#undef PG8_LDB
#undef PG8_MMA
#undef PG8_WAIT_V
#undef PG8_WAIT_L
#undef PG8_BAR
#undef PG8_SCHED
}
}

constexpr int D_MODEL = 1024, BATCH = 32, SEQ = 2048, MROWS = BATCH * SEQ;
constexpr int NWAVES = 8, NTHREADS = 512;
constexpr float LOG2E = 1.4426950408889634f;
constexpr float RMS_EPS_ = 1e-6f;
constexpr float LAMBDA_INIT = 0.2f;
constexpr int C_QA = 0, C_KA = 512, C_VA = 640, C_GA = 768, C_QB = 1280, C_KB = 1792, C_VB = 2304, C_GB = 2816;

#define LAS __attribute__((address_space(3)))
typedef unsigned short bf16_t;
typedef short bf16x8 __attribute__((ext_vector_type(8)));
typedef short s16x4 __attribute__((ext_vector_type(4)));
typedef float f32x4 __attribute__((ext_vector_type(4)));
typedef float f32x16 __attribute__((ext_vector_type(16)));
typedef unsigned u32x4 __attribute__((ext_vector_type(4)));
typedef unsigned u32x2 __attribute__((ext_vector_type(2)));
using pg8::cvt_pk_bf16; using pg8::PROJ_W;

constexpr size_t MiB = 1u << 20;
constexpr size_t WS_MODP = 0;
constexpr size_t WS_CTL = 12 * MiB, CTL_BYTES = 16384;
constexpr size_t WS_MOD = 8 * MiB;
constexpr size_t WS_WIN = 16 * MiB;
constexpr size_t WS_WOUT = 24 * MiB;
constexpr size_t WS_ROPE = 32 * MiB;
constexpr size_t WS_H = 64 * MiB;
constexpr size_t WS_Y = WS_H;
constexpr size_t WS_PROJ = 192 * MiB;
constexpr size_t WS_END = WS_PROJ + (size_t)MROWS * 3328 * 2;

constexpr int LDS_BYTES = 147456;

__device__ __forceinline__ float wave_sum(float v) {
#pragma unroll
    for (int o = 1; o < 64; o <<= 1) v += __shfl_xor(v, o);
    return v;
}
__device__ __forceinline__ unsigned f2bf(float f) { unsigned u = __builtin_bit_cast(unsigned, f); return (u + 0x7fffu + ((u >> 16) & 1u)) >> 16; }
__device__ __forceinline__ unsigned pk2(float lo, float hi) { return cvt_pk_bf16(lo, hi); }
__device__ __forceinline__ float bf_lo(unsigned w) { return __builtin_bit_cast(float, w << 16); }
__device__ __forceinline__ float bf_hi(unsigned w) { return __builtin_bit_cast(float, w & 0xffff0000u); }

__device__ __forceinline__ void p0_transpose_item(const float* W, int K, int N, bf16_t* WT, bool headperm, LAS float* scr, int item, int lane) {
    const int nblk = N / 32, kb = item / nblk, nb = item % nblk, k0 = 64 * kb, n0 = 32 * nb;
    const int prow0 = headperm ? ((n0 & ~255) + 128 * ((n0 >> 5) & 1) + 32 * ((n0 >> 6) & 3)) : n0;
#pragma unroll 8
    for (int i = 0; i < 32; ++i) { const int kk = 2 * i + (lane >> 5); scr[kk * 33 + (lane & 31)] = W[(size_t)(k0 + kk) * N + n0 + (lane & 31)]; }
    __builtin_amdgcn_s_waitcnt(0xc07f); asm volatile("s_waitcnt lgkmcnt(0)" ::: "memory");
    const int c = lane & 7;
#pragma unroll
    for (int j = 0; j < 4; ++j) { const int n = (lane >> 3) + 8 * j; const LAS float* s = scr + (8 * c) * 33 + n;
        u32x4 o; o.x = pk2(s[0 * 33], s[1 * 33]); o.y = pk2(s[2 * 33], s[3 * 33]); o.z = pk2(s[4 * 33], s[5 * 33]); o.w = pk2(s[6 * 33], s[7 * 33]);
        *(u32x4*)(WT + (size_t)(prow0 + n) * K + k0 + 8 * c) = o; }
    asm volatile("s_waitcnt lgkmcnt(0)" ::: "memory");
}

__device__ __forceinline__ void p0_mod_item(const float* c, const float* w_ada, float* modp, LAS float* scr, int item, int lane) {
    const int kc = item / 48, cgp = item % 48, k0 = kc * 64, n = cgp * 64 + lane;
    float w[64];
#pragma unroll
    for (int k = 0; k < 64; ++k) w[k] = w_ada[(size_t)(k0 + k) * 3072 + n];
    {
        const int b = lane & 31, kh = lane >> 5;
#pragma unroll 8
        for (int kk = 0; kk < 32; ++kk) { const int k = 2 * kk + kh; const float v = c[b * 1024 + k0 + k]; scr[k * 32 + b] = v / (1.0f + __expf(-v)); }
    }
    asm volatile("s_waitcnt lgkmcnt(0)" ::: "memory");
    float acc[32];
#pragma unroll
    for (int b = 0; b < 32; ++b) acc[b] = 0.f;
#pragma unroll
    for (int k = 0; k < 64; ++k) {
#pragma unroll
        for (int b4 = 0; b4 < 8; ++b4) { const f32x4 sv = *(const LAS f32x4*)(scr + k * 32 + 4 * b4); acc[4 * b4] += sv[0] * w[k]; acc[4 * b4 + 1] += sv[1] * w[k]; acc[4 * b4 + 2] += sv[2] * w[k]; acc[4 * b4 + 3] += sv[3] * w[k]; }
    }
#pragma unroll
    for (int b = 0; b < 32; ++b) modp[((size_t)kc * 32 + b) * 3072 + n] = acc[b];
    asm volatile("s_waitcnt lgkmcnt(0)" ::: "memory");
}

__device__ __forceinline__ void p0_rope(const int* positions, float* rope, int idx, float inv_freq) {
    const int r = idx >> 5, i = idx & 31;
    const float angf = (float)positions[r] * inv_freq;
    const double a = (double)angf;
    const double nq = rint(a * 0.63661977236758134308);
    const double rr = (a - nq * 1.57079632679489655800) - nq * 6.12323399573676603587e-17;
    const double r2 = rr * rr;
    const double sn = rr * (1.0 + r2 * (-1.0 / 6 + r2 * (1.0 / 120 + r2 * (-1.0 / 5040 + r2 * (1.0 / 362880 + r2 * (-1.0 / 39916800 + r2 * (1.0 / 6227020800.0)))))));
    const double cs = 1.0 + r2 * (-0.5 + r2 * (1.0 / 24 + r2 * (-1.0 / 720 + r2 * (1.0 / 40320 + r2 * (-1.0 / 3628800 + r2 * (1.0 / 479001600 + r2 * (-1.0 / 87178291200.0)))))));
    const int q = ((int)(long long)nq) & 3;
    const double s = (q == 0) ? sn : (q == 1) ? cs : (q == 2) ? -sn : -cs;
    const double cc = (q == 0) ? cs : (q == 1) ? -sn : (q == 2) ? -cs : sn;
    rope[(size_t)r * 64 + i] = (float)cc; rope[(size_t)r * 64 + 32 + i] = (float)s;
}

struct Ptrs {
    const float *x, *c; const int* positions; const float *w_ada, *b_ada, *norm_gain, *w_in, *q_norm_a, *k_norm_a, *sink_a, *q_norm_b, *k_norm_b, *lq1, *lk1, *lq2, *lk2, *subln, *w_out;
    float* out; unsigned char* ws; int ph_lo, ph_hi;
};

__device__ __forceinline__ void phase0(const Ptrs& P, LAS unsigned char* lds, int wave, int lane) {
    LAS float* scr = (LAS float*)(lds + wave * 16384);
    const int gw = blockIdx.x * NWAVES + wave, NGW = gridDim.x * NWAVES;
    constexpr int I_MOD = 16 * 48, I_IN = (1024 / 64) * (3328 / 32), I_OUT = (1024 / 64) * (1024 / 32);
    constexpr int NITEMS = I_MOD + I_IN + I_OUT;
    float* modp = (float*)(P.ws + WS_MODP);
    const int nmodw = (NGW >= 2 * I_MOD) ? I_MOD : 0;
    if (gw < nmodw) p0_mod_item(P.c, P.w_ada, modp, scr, gw, lane);
    else {
        for (int it = gw - nmodw + (nmodw ? I_MOD : 0); it < NITEMS; it += NGW - nmodw) {
            int r = it;
            if (r < I_MOD) { p0_mod_item(P.c, P.w_ada, modp, scr, r, lane); continue; } r -= I_MOD;
            if (r < I_IN) { p0_transpose_item(P.w_in, 1024, 3328, (bf16_t*)(P.ws + WS_WIN), true, scr, r, lane); continue; } r -= I_IN;
            p0_transpose_item(P.w_out, 1024, 1024, (bf16_t*)(P.ws + WS_WOUT), false, scr, r, lane);
        }
    }
    float* rope = (float*)(P.ws + WS_ROPE);
    const float inv_freq = 1.0f / powf(10000.0f, (float)(2 * (threadIdx.x & 31)) / 64.0f);
    for (int idx = blockIdx.x * NTHREADS + threadIdx.x; idx < MROWS * 32; idx += gridDim.x * NTHREADS) p0_rope(P.positions, rope, idx, inv_freq);
}

__device__ __forceinline__ void phase1(const Ptrs& P, LAS unsigned char* lds, int wave, int lane) {
    LAS float* sh_gs = (LAS float*)lds;
    LAS float* sh_sf = (LAS float*)(lds + 4096);
    const float* modp = (const float*)(P.ws + WS_MODP);
    float* mod = (float*)(P.ws + WS_MOD);
    bf16_t* H = (bf16_t*)(P.ws + WS_H);
    for (int t = blockIdx.x; t < MROWS / 256; t += gridDim.x) {
        const int b = t >> 3;
        __syncthreads();
        for (int n = threadIdx.x; n < 3072; n += NTHREADS) {
            if (n >= 2048 && (t & 7) != 0) break;
            float s = P.b_ada[n];
#pragma unroll
            for (int kc = 0; kc < 16; ++kc) s += modp[((size_t)kc * 32 + b) * 3072 + n];
            if (n < 1024) sh_sf[n] = s;
            else if (n < 2048) sh_gs[n - 1024] = P.norm_gain[n - 1024] * (1.0f + s);
            else mod[(size_t)b * 3072 + n] = s;
        }
        __syncthreads();
        f32x4 v[4][4], vn[4][4];
        {
            const f32x4* xr = (const f32x4*)(P.x + ((size_t)t * 256 + wave * 32) * 1024) + lane;
#pragma unroll
            for (int q = 0; q < 4; ++q)
#pragma unroll
                for (int j = 0; j < 4; ++j) v[q][j] = __builtin_nontemporal_load(xr + q * 256 + 64 * j);
        }
        for (int rr = 0; rr < 32; rr += 4) {
            const size_t row = (size_t)t * 256 + wave * 32 + rr;
            if (rr + 4 < 32) {
                const f32x4* xr = (const f32x4*)(P.x + (row + 4) * 1024) + lane;
#pragma unroll
                for (int q = 0; q < 4; ++q)
#pragma unroll
                    for (int j = 0; j < 4; ++j) vn[q][j] = __builtin_nontemporal_load(xr + q * 256 + 64 * j);
            }
            float s[4];
#pragma unroll
            for (int q = 0; q < 4; ++q) { s[q] = 0.f;
#pragma unroll
                for (int j = 0; j < 4; ++j) s[q] += (v[q][j].x * v[q][j].x + v[q][j].y * v[q][j].y) + (v[q][j].z * v[q][j].z + v[q][j].w * v[q][j].w); }
#pragma unroll
            for (int o = 1; o < 64; o <<= 1) {
#pragma unroll
                for (int q = 0; q < 4; ++q) s[q] += __shfl_xor(s[q], o); }
#pragma unroll
            for (int q = 0; q < 4; ++q) {
                const float rstd = rsqrtf(s[q] * (1.f / 1024) + RMS_EPS_);
                u32x2* o8 = (u32x2*)(H + (row + q) * 1024) + lane;
#pragma unroll
                for (int j = 0; j < 4; ++j) {
                    const f32x4 g = *(const LAS f32x4*)(sh_gs + 256 * j + 4 * lane), sf = *(const LAS f32x4*)(sh_sf + 256 * j + 4 * lane);
                    const f32x4 hv = v[q][j] * rstd * g + sf;
                    u32x2 w; w.x = pk2(hv.x, hv.y); w.y = pk2(hv.z, hv.w); o8[64 * j] = w;
                }
            }
#pragma unroll
            for (int q = 0; q < 4; ++q)
#pragma unroll
                for (int j = 0; j < 4; ++j) v[q][j] = vn[q][j];
        }
    }
}

__device__ __forceinline__ unsigned off_b(unsigned row, unsigned ch) { return 256u * row + 16u * (ch ^ (((row & 3) << 2) | ((row >> 2) & 3))); }
__device__ __forceinline__ int crow(int r, int hi) { return (r & 3) + 8 * (r >> 2) + 4 * hi; }
__device__ __forceinline__ s16x4 vtr(const LAS unsigned char* p) { typedef short v4i16_t __attribute__((ext_vector_type(4))); return __builtin_bit_cast(s16x4, __builtin_amdgcn_ds_read_tr16_b64_v4i16((LAS v4i16_t*)p)); }
#define MFMA32(a, b, c) __builtin_amdgcn_mfma_f32_32x32x16_bf16((a), (b), (c), 0, 0, 0)

typedef const LAS unsigned char* ldsp_t;
__device__ __forceinline__ ldsp_t lxor(ldsp_t p, unsigned c) { return (ldsp_t)((unsigned)(uintptr_t)p ^ c); }
template <int NEB, bool MASK, bool QLDS, int KCH0, int VCH0, int QCH0>
__device__ __forceinline__ void att_half(ldsp_t kaddr, ldsp_t vaddr, ldsp_t qaddr, const bf16x8 (&qf)[4], f32x16 (&o)[NEB], float& l, float negm, int hi, int dq0  ) {
    f32x16 s;
#pragma unroll
    for (int i = 0; i < 16; ++i) s[i] = negm;
#pragma unroll
    for (int ks = 0; ks < 4; ++ks) {
        const bf16x8 kf = *(const LAS bf16x8*)lxor(kaddr, 16u * (KCH0 + 2 * ks));
        bf16x8 qv;
        if (QLDS) qv = *(const LAS bf16x8*)lxor(qaddr, 16u * (QCH0 + 2 * ks)); else qv = qf[ks];
        s = MFMA32(kf, qv, s);
    }
    float sum = 0.f;
#pragma unroll
    for (int i = 0; i < 16; ++i) {
        float p = __builtin_amdgcn_exp2f(s[i]);
        if (MASK) { const int d = dq0 - crow(i, hi); p = (d <= 128 && d >= -128) ? p : 0.f; }
        s[i] = p; sum += p;
    }
    l += sum;
    u32x4 w0, w1;
    w0.x = cvt_pk_bf16(s[0], s[1]); w0.y = cvt_pk_bf16(s[2], s[3]); w0.z = cvt_pk_bf16(s[4], s[5]); w0.w = cvt_pk_bf16(s[6], s[7]);
    w1.x = cvt_pk_bf16(s[8], s[9]); w1.y = cvt_pk_bf16(s[10], s[11]); w1.z = cvt_pk_bf16(s[12], s[13]); w1.w = cvt_pk_bf16(s[14], s[15]);
    const bf16x8 pk0 = __builtin_bit_cast(bf16x8, w0), pk1 = __builtin_bit_cast(bf16x8, w1);
#pragma unroll
    for (int eb = 0; eb < NEB; ++eb) {
        const ldsp_t a0 = lxor(vaddr, 64u * (VCH0 / 4 + eb)), a1 = lxor(vaddr, (64u * (VCH0 / 4 + eb)) ^ 32u);
#pragma unroll
        for (int u = 0; u < 2; ++u) {
            const s16x4 lo = vtr(a0 + 4096 * u);
            const s16x4 hh = vtr(a1 + 4096 * u + 2048);
            const bf16x8 vf = (bf16x8){lo[0], lo[1], lo[2], lo[3], hh[0], hh[1], hh[2], hh[3]};
            o[eb] = MFMA32(vf, u == 0 ? pk0 : pk1, o[eb]);
        }
    }
}
__device__ __forceinline__ unsigned lane_kL(int r32, int hi) { const unsigned xk = ((r32 & 3) << 2) | ((r32 >> 2) & 3); return 256u * r32 + 16u * ((unsigned)hi ^ xk); }
__device__ __forceinline__ unsigned lane_vL(int lane, int hi) { const unsigned blk = (lane >> 4) & 1, q = (lane & 15) >> 2, p = lane & 3; return 256u * (4 * hi + q) + 64u * q + ((32u * blk + 16u * (p >> 1)) ^ (16u * hi)) + 8u * (p & 1); }

__device__ __forceinline__ void glds16(const void* gsrc, unsigned lds_dst) { unsigned keep;
    asm volatile("s_mov_b32 %0, m0\n\ts_mov_b32 m0, %2\n\ts_nop 0\n\tglobal_load_lds_dwordx4 %1, off\n\ts_mov_b32 m0, %0" : "=&s"(keep) : "v"(gsrc), "s"(lds_dst) : "memory"); }
__device__ __forceinline__ f32x16 qk_half(ldsp_t kaddr, const bf16x8 (&qf)[4], float negm) {
    f32x16 s;
#pragma unroll
    for (int i = 0; i < 16; ++i) s[i] = negm;
#pragma unroll
    for (int ks = 0; ks < 4; ++ks) { const bf16x8 kf = *(const LAS bf16x8*)lxor(kaddr, 32u * ks); s = MFMA32(kf, qf[ks], s); }
    return s;
}
__device__ __forceinline__ void exp_pack(f32x16& s, float& l, bf16x8& pk0, bf16x8& pk1) {
    float sum = 0.f;
#pragma unroll
    for (int i = 0; i < 16; ++i) { s[i] = __builtin_amdgcn_exp2f(s[i]); sum += s[i]; }
    l += sum;
    u32x4 w0, w1;
    w0.x = cvt_pk_bf16(s[0], s[1]); w0.y = cvt_pk_bf16(s[2], s[3]); w0.z = cvt_pk_bf16(s[4], s[5]); w0.w = cvt_pk_bf16(s[6], s[7]);
    w1.x = cvt_pk_bf16(s[8], s[9]); w1.y = cvt_pk_bf16(s[10], s[11]); w1.z = cvt_pk_bf16(s[12], s[13]); w1.w = cvt_pk_bf16(s[14], s[15]);
    pk0 = __builtin_bit_cast(bf16x8, w0); pk1 = __builtin_bit_cast(bf16x8, w1);
}
template <int NEB, int VB = 0>
__device__ __forceinline__ void pv_half(ldsp_t vaddr, const bf16x8 pk0, const bf16x8 pk1, f32x16 (&o)[NEB]) {
#pragma unroll
    for (int eb = 0; eb < NEB; ++eb) {
        const ldsp_t a0 = lxor(vaddr, 64u * (VB + eb)), a1 = lxor(vaddr, (64u * (VB + eb)) ^ 32u);
#pragma unroll
        for (int u = 0; u < 2; ++u) {
            const s16x4 lo = vtr(a0 + 4096 * u);
            const s16x4 hh = vtr(a1 + 4096 * u + 2048);
            const bf16x8 vf = (bf16x8){lo[0], lo[1], lo[2], lo[3], hh[0], hh[1], hh[2], hh[3]};
            o[eb] = MFMA32(vf, u == 0 ? pk0 : pk1, o[eb]);
        }
    }
}

__device__ __forceinline__ void attnB_stream(LAS unsigned char* lds, const bf16_t* proj, bf16_t* y, const float* subln, int u0, int ustride, int nunits, float negm, float lam) {
    const int tid = threadIdx.x, lane = tid & 63, wid = __builtin_amdgcn_readfirstlane(tid >> 6), r32 = lane & 31, hi = lane >> 5;
    const int c = wid >> 2, rg = wid & 3;
    const int img = wid >> 2;
    unsigned goff[4];
#pragma unroll
    for (int i = 0; i < 4; ++i) goff[i] = (unsigned)((16 * (wid & 3) + 4 * i + (lane >> 4)) * PROJ_W + 8 * ((lane & 15) ^ (((lane >> 4) << 2) | i))) * 2u;
    const unsigned dst0 = img * 16384 + (4 * (wid & 3)) * 1024;
    const unsigned ldsbase = (unsigned)(uintptr_t)lds;
#define UNIT_GSRC(u) ((const char*)(proj + (size_t)((u) >> 6) * SEQ * PROJ_W + (img ? C_VB : C_KB) + 128 * (((u) >> 4) & 3)))
#define DMA_TILE(gs0, t, bufoff) do { const char* gs_ = (gs0) + (size_t)(t) * (64 * PROJ_W * 2); _Pragma("unroll") for (int i_ = 0; i_ < 4; ++i_) \
        glds16(gs_ + goff[i_], (unsigned)__builtin_amdgcn_readfirstlane(ldsbase + (bufoff) + dst0 + i_ * 1024)); } while (0)
#define LOAD_Q(u) do { const bf16_t* qp_ = proj + ((size_t)((u) >> 6) * SEQ + ((u) & 15) * 128 + rg * 32 + r32) * PROJ_W + C_QB + 128 * (((u) >> 4) & 3) + 64 * c + 8 * hi; \
        _Pragma("unroll") for (int s_ = 0; s_ < 4; ++s_) qf[s_] = *(const bf16x8*)(qp_ + 16 * s_); } while (0)
    LAS float* sh_gain = (LAS float*)(lds + 131072 + 2048);
    if (tid < 128) sh_gain[tid] = subln[tid];
    if (u0 >= nunits) return;
    int b0 = 0, b1 = 32768, b2 = 65536;
    bf16x8 qf[4];
    { const char* g0 = UNIT_GSRC(u0); DMA_TILE(g0, 0, b0); DMA_TILE(g0, 1, b1); LOAD_Q(u0); }
    unsigned kL = lane_kL(r32, hi) ^ (128u * c), vL = lane_vL(lane, hi);
    for (int u = u0; u < nunits; u += ustride) {
        const int un = u + ustride; const bool has_next = un < nunits;
        const char* gcur = UNIT_GSRC(u); const char* gnxt = UNIT_GSRC(has_next ? un : u);
        const int qb = u & 15, h = (u >> 4) & 3, b = u >> 6;
        const size_t qrow = (size_t)b * SEQ + qb * 128 + rg * 32 + r32;
        f32x16 o[4];
#pragma unroll
        for (int e = 0; e < 4; ++e)
#pragma unroll
            for (int i = 0; i < 16; ++i) o[e][i] = 0.f;
        float l = 0.f;
        if (u == u0) asm volatile("s_waitcnt vmcnt(0)" ::: "memory");
        __syncthreads();
#define SB_STAGE() __builtin_amdgcn_sched_barrier(0x2 | 0x4 | 0x400)
#define KLOAD(dst, base) do { _Pragma("unroll") for (int ks_ = 0; ks_ < 4; ++ks_) dst[ks_] = *(const LAS bf16x8*)lxor((base), 32u * ks_); } while (0)
#define VLOAD(dst, base, eb0) do { _Pragma("unroll") for (int e_ = 0; e_ < 2; ++e_) { const ldsp_t a0_ = lxor((base), 64u * ((eb0) + e_)), a1_ = lxor((base), (64u * ((eb0) + e_)) ^ 32u); \
            _Pragma("unroll") for (int u_ = 0; u_ < 2; ++u_) { const s16x4 lo_ = vtr(a0_ + 4096 * u_); const s16x4 hh_ = vtr(a1_ + 4096 * u_ + 2048); \
                dst[e_][u_] = (bf16x8){lo_[0], lo_[1], lo_[2], lo_[3], hh_[0], hh_[1], hh_[2], hh_[3]}; } } } while (0)
#define QKMMA(sd, kf) do { _Pragma("unroll") for (int ks_ = 0; ks_ < 4; ++ks_) sd = MFMA32(kf[ks_], qf[ks_], ks_ == 0 ? negv : sd); } while (0)
#define PVMMA(vf, eb0, p0, p1) do { _Pragma("unroll") for (int e_ = 0; e_ < 2; ++e_) { o[(eb0) + e_] = MFMA32(vf[e_][0], p0, o[(eb0) + e_]); o[(eb0) + e_] = MFMA32(vf[e_][1], p1, o[(eb0) + e_]); } } while (0)
        f32x16 negv;
#pragma unroll
        for (int i = 0; i < 16; ++i) negv[i] = negm;
        asm volatile("" : "+v"(negv));
        bf16x8 kfa[4], kfb[4], vfa[2][2], vfb[2][2], pa, pb, pc, pd;
        f32x16 s0, s1;
        KLOAD(kfa, lds + b0 + kL);
        KLOAD(kfb, lds + b0 + 8192 + kL);
        QKMMA(s0, kfa);
        for (int t = 0; t < 32; ++t) {
            asm volatile("" : "+v"(kL), "+v"(vL));
            if (t + 2 < 32) DMA_TILE(gcur, t + 2, b2); else if (has_next) DMA_TILE(gnxt, t - 30, b2);
            ldsp_t vb = lds + b0 + 16384 + vL, kn = lds + b1 + kL;
            VLOAD(vfa, vb, 0);
            QKMMA(s1, kfb);
            exp_pack(s0, l, pa, pb);
            SB_STAGE();
            VLOAD(vfb, vb, 2);
            PVMMA(vfa, 0, pa, pb);
            SB_STAGE();
            KLOAD(kfa, kn);
            PVMMA(vfb, 2, pa, pb);
            exp_pack(s1, l, pc, pd);
            SB_STAGE();
            VLOAD(vfa, vb + 8192, 0);
            QKMMA(s0, kfa);
            SB_STAGE();
            VLOAD(vfb, vb + 8192, 2);
            PVMMA(vfa, 0, pc, pd);
            SB_STAGE();
            KLOAD(kfb, kn + 8192);
            PVMMA(vfb, 2, pc, pd);
            asm volatile("s_waitcnt vmcnt(0)" ::: "memory");
            __syncthreads();
            const int tmp = b0; b0 = b1; b1 = b2; b2 = tmp;
        }
#undef SB_STAGE
#undef KLOAD
#undef VLOAD
#undef QKMMA
#undef PVMMA
        if (has_next) LOAD_Q(un);
        l += __shfl_xor(l, 32);
        LAS float* xch = (LAS float*)(lds + (rg < 2 ? b2 + rg * 16384 : 98304 + (rg - 2) * 16384)) + r32;
        const bf16_t* gp = proj + qrow * PROJ_W + C_GB + 128 * h + 8 * hi;
        if (c == 1) {
            const float i1 = lam / l;
#pragma unroll
            for (int e = 0; e < 4; ++e)
#pragma unroll
                for (int i = 0; i < 16; ++i) xch[(32 * e + crow(i, hi)) * 32] = o[e][i] * i1;
        }
        __syncthreads();
        if (c == 0) {
            u32x4 gc[2], gn2[2];
#pragma unroll
            for (int k = 0; k < 2; ++k) gc[k] = *(const u32x4*)(gp + 16 * k);
            const float i0 = 1.0f / l;
            float ss = 0.f;
#pragma unroll
            for (int e = 0; e < 4; ++e)
#pragma unroll
                for (int i = 0; i < 16; ++i) { const float v = o[e][i] * i0 - xch[(32 * e + crow(i, hi)) * 32]; o[e][i] = v; ss += v * v; }
            ss += __shfl_xor(ss, 32);
            const float rstd = rsqrtf(ss * (1.0f / 128.0f) + RMS_EPS_) * (1.0f - LAMBDA_INIT);
            bf16_t* yp16 = y + qrow * 1024 + 512 + 128 * h + 8 * hi;
#pragma unroll
            for (int e = 0; e < 4; ++e) {
                if (e < 3) {
#pragma unroll
                    for (int k = 0; k < 2; ++k) gn2[k] = *(const u32x4*)(gp + 32 * (e + 1) + 16 * k);
                }
#pragma unroll
                for (int k = 0; k < 2; ++k) {
                    float lo4[4], hi4[4];
#pragma unroll
                    for (int j = 0; j < 4; ++j) {
                        const auto r = __builtin_amdgcn_permlane32_swap(__float_as_uint(o[e][8 * k + j]), __float_as_uint(o[e][8 * k + 4 + j]), false, false);
                        lo4[j] = __uint_as_float(r[0]); hi4[j] = __uint_as_float(r[1]);
                    }
                    const f32x4 ga = *(const LAS f32x4*)(sh_gain + 32 * e + 16 * k + 8 * hi), gb = *(const LAS f32x4*)(sh_gain + 32 * e + 16 * k + 8 * hi + 4);
                    const u32x4 g4v = gc[k];
                    u32x4 w4;
                    w4.x = pk2(lo4[0] * rstd * ga[0] * bf_lo(g4v.x), lo4[1] * rstd * ga[1] * bf_hi(g4v.x)); w4.y = pk2(lo4[2] * rstd * ga[2] * bf_lo(g4v.y), lo4[3] * rstd * ga[3] * bf_hi(g4v.y));
                    w4.z = pk2(hi4[0] * rstd * gb[0] * bf_lo(g4v.z), hi4[1] * rstd * gb[1] * bf_hi(g4v.z)); w4.w = pk2(hi4[2] * rstd * gb[2] * bf_lo(g4v.w), hi4[3] * rstd * gb[3] * bf_hi(g4v.w));
                    *(u32x4*)(yp16 + 32 * e + 16 * k) = w4;
                }
#pragma unroll
                for (int k = 0; k < 2; ++k) gc[k] = gn2[k];
                asm volatile("" ::: "memory");
            }
        }
    }
#undef DMA_TILE
#undef UNIT_GSRC
#undef LOAD_Q
    __syncthreads();
}

__device__ __forceinline__ void attnA_strip(LAS unsigned char* lds, const bf16_t* proj, bf16_t* y, const float* sink, int b, int kvh, int qb0, int nq, float negm) {
    const int tid = threadIdx.x, lane = tid & 63, wid = __builtin_amdgcn_readfirstlane(tid >> 6), r32 = lane & 31, hi = lane >> 5;
    const size_t rowbase = (size_t)b * SEQ;
    const char* gsrc = (const char*)(proj + rowbase * PROJ_W);
    unsigned goff[2];
#pragma unroll
    for (int j = 0; j < 2; ++j) {
        const int blk = 2 * wid + j, row = 4 * blk + (lane >> 4);
        const int ch = (lane & 15) ^ (((lane >> 4) << 2) | (blk & 3));
        const int col = (ch < 8) ? (C_KA + 64 * kvh + 8 * ch) : (C_VA + 64 * kvh + 8 * (ch - 8));
        goff[j] = (unsigned)(row * PROJ_W + col) * 2u;
    }
    const unsigned ldsbase = (unsigned)(uintptr_t)lds;
#define DMA_TILE_A(kt) do { if ((kt) >= 0 && (kt) < 32) { const char* gs_ = gsrc + (size_t)(kt) * (64 * PROJ_W * 2); const unsigned so_ = ((kt) % 6) * 16384 + 2 * wid * 1024; \
        glds16(gs_ + goff[0], (unsigned)__builtin_amdgcn_readfirstlane(ldsbase + so_)); glds16(gs_ + goff[1], (unsigned)__builtin_amdgcn_readfirstlane(ldsbase + so_ + 1024)); } } while (0)
    for (int kt = qb0 - 2; kt <= qb0 + 2; ++kt) DMA_TILE_A(kt);
    const int g = wid & 3, rg = wid >> 2, head = 4 * kvh + g;
    const float sinkv = __builtin_amdgcn_exp2f(sink[head] * LOG2E + negm);
    unsigned kL = lane_kL(r32, hi), vL = lane_vL(lane, hi);
    bf16x8 qf[4];
    {
        const bf16_t* qp = proj + (rowbase + 64 * qb0 + 32 * rg + r32) * PROJ_W + C_QA + 64 * head + 8 * hi;
#pragma unroll
        for (int s = 0; s < 4; ++s) qf[s] = *(const bf16x8*)(qp + 16 * s);
    }
    for (int iq = 0; iq < nq; ++iq) {
        const int qb = qb0 + iq;
        const int qpos = 64 * qb + 32 * rg + r32;
        const size_t qrow = rowbase + qpos;
        f32x16 o[2];
#pragma unroll
        for (int e = 0; e < 2; ++e)
#pragma unroll
            for (int i = 0; i < 16; ++i) o[e][i] = 0.f;
        float l = 0.f;
        if (iq == 0) asm volatile("s_waitcnt vmcnt(0)" ::: "memory"); else asm volatile("s_waitcnt vmcnt(8)" ::: "memory");
        __syncthreads();
        if (iq + 1 < nq) DMA_TILE_A(qb + 3);
        const bf16_t* gp = proj + qrow * PROJ_W + C_GA + 64 * head + 8 * hi;
        u32x4 gt[2][2];
#pragma unroll
        for (int e = 0; e < 2; ++e)
#pragma unroll
            for (int k = 0; k < 2; ++k) gt[e][k] = *(const u32x4*)(gp + 32 * e + 16 * k);
        bf16x8 qn[4];
        {
            const bf16_t* qp = proj + (qrow + ((iq + 1 < nq) ? 64 : 0)) * PROJ_W + C_QA + 64 * head + 8 * hi;
#pragma unroll
            for (int s = 0; s < 4; ++s) qn[s] = *(const bf16x8*)(qp + 16 * s);
        }
        const int qw0 = 64 * qb + 32 * rg;
        const int i_lo = (qw0 - 128 < 0) ? ((128 - qw0) >> 5) : 0;
        const int i_hi = (qw0 + 128 > SEQ - 32) ? ((SEQ - 32 - qw0 + 128) >> 5) : 8;
#define HALF_IMG(i) (lds + (((qw0 - 128 + 32 * (i)) >> 6) % 6) * 16384 + (((qw0 - 128 + 32 * (i)) >> 5) & 1) * 8192)
#define KLOAD_A(dst, base) do { _Pragma("unroll") for (int ks_ = 0; ks_ < 4; ++ks_) dst[ks_] = *(const LAS bf16x8*)lxor((base), 32u * ks_); } while (0)
#define QK_A(sd, kf) do { _Pragma("unroll") for (int ks_ = 0; ks_ < 4; ++ks_) sd = MFMA32(kf[ks_], qf[ks_], ks_ == 0 ? negv : sd); } while (0)
        f32x16 negv;
#pragma unroll
        for (int r = 0; r < 16; ++r) negv[r] = negm;
        asm volatile("" : "+v"(negv));
        bf16x8 kfn[4], vf[2][2];
        f32x16 sc, sn;
#define A_STEP(MASKED) do { \
            asm volatile("" : "+v"(kL), "+v"(vL)); \
            const int n1_ = (i + 2 < i_hi) ? i + 2 : i_hi; \
            ldsp_t va_ = HALF_IMG(i) + vL; \
            _Pragma("unroll") for (int eb = 0; eb < 2; ++eb) { const ldsp_t a0 = lxor(va_, 64u * (2 + eb)), a1 = lxor(va_, (64u * (2 + eb)) ^ 32u); \
                _Pragma("unroll") for (int u = 0; u < 2; ++u) { const s16x4 lo = vtr(a0 + 4096 * u); const s16x4 hh = vtr(a1 + 4096 * u + 2048); vf[eb][u] = (bf16x8){lo[0], lo[1], lo[2], lo[3], hh[0], hh[1], hh[2], hh[3]}; } } \
            QK_A(sn, kfn); \
            __builtin_amdgcn_sched_barrier(0x2 | 0x4 | 0x400); \
            KLOAD_A(kfn, HALF_IMG(n1_) + kL); \
            _Pragma("unroll") for (int r = 0; r < 16; ++r) sc[r] = __builtin_amdgcn_exp2f(sc[r]); \
            if (MASKED) { const int dq0 = qpos - (qw0 - 128 + 32 * i); \
                _Pragma("unroll") for (int r = 0; r < 16; ++r) { const int d = dq0 - crow(r, hi); sc[r] = (d <= 128 && d >= -128) ? sc[r] : 0.f; } } \
            float sum = 0.f; \
            _Pragma("unroll") for (int r = 0; r < 16; ++r) sum += sc[r]; \
            l += sum; \
            u32x4 w0, w1; \
            w0.x = cvt_pk_bf16(sc[0], sc[1]); w0.y = cvt_pk_bf16(sc[2], sc[3]); w0.z = cvt_pk_bf16(sc[4], sc[5]); w0.w = cvt_pk_bf16(sc[6], sc[7]); \
            w1.x = cvt_pk_bf16(sc[8], sc[9]); w1.y = cvt_pk_bf16(sc[10], sc[11]); w1.z = cvt_pk_bf16(sc[12], sc[13]); w1.w = cvt_pk_bf16(sc[14], sc[15]); \
            const bf16x8 pk0 = __builtin_bit_cast(bf16x8, w0), pk1 = __builtin_bit_cast(bf16x8, w1); \
            _Pragma("unroll") for (int eb = 0; eb < 2; ++eb) { o[eb] = MFMA32(vf[eb][0], pk0, o[eb]); o[eb] = MFMA32(vf[eb][1], pk1, o[eb]); } \
            sc = sn; } while (0)
        KLOAD_A(kfn, HALF_IMG(i_lo) + kL);
        QK_A(sc, kfn);
        KLOAD_A(kfn, HALF_IMG((i_lo + 1 < i_hi) ? i_lo + 1 : i_hi) + kL);
        int i = i_lo;
        if (i == 0) { A_STEP(true); ++i; }
        const int i_end = (i_hi == 8) ? 7 : i_hi;
#pragma unroll 2
        for (; i <= i_end; ++i) A_STEP(false);
        if (i_hi == 8) A_STEP(true);
#undef A_STEP
#undef KLOAD_A
#undef QK_A
#undef HALF_IMG
        l += __shfl_xor(l, 32);
        l += sinkv;
        const float inv = 1.0f / l;
        bf16_t* yp16 = y + qrow * 1024 + 64 * head + 8 * hi;
#pragma unroll
        for (int e = 0; e < 2; ++e)
#pragma unroll
            for (int k = 0; k < 2; ++k) {
                float lo4[4], hi4[4];
#pragma unroll
                for (int j = 0; j < 4; ++j) {
                    const auto r = __builtin_amdgcn_permlane32_swap(__float_as_uint(o[e][8 * k + j]), __float_as_uint(o[e][8 * k + 4 + j]), false, false);
                    lo4[j] = __uint_as_float(r[0]); hi4[j] = __uint_as_float(r[1]);
                }
                const u32x4 g4v = gt[e][k];
                u32x4 w4;
                w4.x = pk2(lo4[0] * inv * bf_lo(g4v.x), lo4[1] * inv * bf_hi(g4v.x)); w4.y = pk2(lo4[2] * inv * bf_lo(g4v.y), lo4[3] * inv * bf_hi(g4v.y));
                w4.z = pk2(hi4[0] * inv * bf_lo(g4v.z), hi4[1] * inv * bf_hi(g4v.z)); w4.w = pk2(hi4[2] * inv * bf_lo(g4v.w), hi4[3] * inv * bf_hi(g4v.w));
                *(u32x4*)(yp16 + 32 * e + 16 * k) = w4;
            }
#pragma unroll
        for (int s = 0; s < 4; ++s) qf[s] = qn[s];
    }
#undef DMA_TILE_A
    __syncthreads();
}

__device__ __forceinline__ float absmax64(const float* g) { float m = 0.f; for (int i = 0; i < 64; ++i) m = fmaxf(m, fabsf(g[i])); return m; }

__device__ __forceinline__ void phase3(const Ptrs& P, LAS unsigned char* lds) {
    const bf16_t* proj = (const bf16_t*)(P.ws + WS_PROJ);
    bf16_t* y = (bf16_t*)(P.ws + WS_Y);
    const float negmA = -(8.0f * absmax64(P.q_norm_a) * absmax64(P.k_norm_a)) * LOG2E;
    const float negmB = -(8.0f * absmax64(P.q_norm_b) * absmax64(P.k_norm_b)) * LOG2E;
    float d1 = 0.f, d2 = 0.f;
    for (int i = 0; i < 64; ++i) { d1 += P.lq1[i] * P.lk1[i]; d2 += P.lq2[i] * P.lk2[i]; }
    const float lam = expf(d1) - expf(d2) + LAMBDA_INIT;
    const int vblk = ((gridDim.x & 7) == 0) ? (int)((blockIdx.x & 7) * (gridDim.x >> 3) + (blockIdx.x >> 3)) : (int)blockIdx.x;
#ifndef NO_ATTB
    for (int rep = 0; rep < REP3B; ++rep) attnB_stream(lds, proj, y, P.subln, vblk, (int)gridDim.x, BATCH * 4 * 16, negmB, lam);
#endif
    __syncthreads();
#ifndef NO_ATTA
    for (int rep = 0; rep < REP3A; ++rep)
    for (int st = vblk; st < BATCH * 2 * 4; st += gridDim.x) {
        const int q8 = st & 3, kvh = (st >> 2) & 1, b = st >> 3;
        attnA_strip(lds, proj, y, P.sink_a, b, kvh, 8 * q8, 8, negmA);
    }
#endif
}

#define XB_TMO      128
#define XB_XCNT(j)  (256  + 64 * (j))
#define XB_XSUB(j)  (1280 + 64 * (j))
#define XB_XGEN(j)  (2304 + 64 * (j))
#define XB_TOP      3328
#define XB_TOPGEN   3392
#define XCD_BAR_WORDS 3456
#define XB_SPIN_CAP (1u << 18)

__device__ __forceinline__ unsigned xb_ld(unsigned* p)              { return __hip_atomic_load(p, __ATOMIC_RELAXED, __HIP_MEMORY_SCOPE_AGENT); }
__device__ __forceinline__ unsigned xb_add(unsigned* p, unsigned v) { return __hip_atomic_fetch_add(p, v, __ATOMIC_RELAXED, __HIP_MEMORY_SCOPE_AGENT); }
__device__ __forceinline__ unsigned xb_xcc_id() { return (unsigned)__builtin_amdgcn_s_getreg((3 << 11) | 20) & 0xFu; }
#define XB_SPIN(cond, bar) do { unsigned _sp = 0; while (cond) { __builtin_amdgcn_s_sleep(1); \
    if ((++_sp & 255u) == 0u) { if (xb_ld(&(bar)[XB_TMO])) break; if (_sp > XB_SPIN_CAP) { atomicAdd(&(bar)[XB_TMO], 1u); break; } } } } while (0)

struct XcdBarrier {
    unsigned* bar; unsigned x;
    volatile LAS unsigned* st;
};

__device__ __forceinline__ XcdBarrier xcd_barrier_post(unsigned* bar, volatile LAS unsigned* st) {
    XcdBarrier b; b.bar = bar; b.x = xb_xcc_id(); b.st = st;
    if (threadIdx.x == 0) (void)xb_add(&bar[XB_XCNT(b.x)], 1u);
    return b;
}
__device__ __forceinline__ void xcd_barrier_complete(unsigned* bar, unsigned x, unsigned& nloc, unsigned& nx) {
    const unsigned G = gridDim.x * gridDim.y * gridDim.z;
    unsigned sum, cnt, mine, sp = 0u;
    for (;;) {
        sum = 0u; cnt = 0u; mine = 0u;
#pragma unroll
        for (unsigned j = 0; j < 16; ++j) { const unsigned c = xb_ld(&bar[XB_XCNT(j)]); sum += c; cnt += (c > 0u) ? 1u : 0u; mine = (j == x) ? c : mine; }
        if (sum == G) break;
        __builtin_amdgcn_s_sleep(1);
        if ((++sp & 255u) == 0u) { if (xb_ld(&bar[XB_TMO])) break; if (sp > XB_SPIN_CAP) { atomicAdd(&bar[XB_TMO], 1u); break; } }
    }
    nloc = mine > 0u ? mine : 1u; nx = cnt > 0u ? cnt : 1u;
}

__device__ __forceinline__ void xcd_barrier(const XcdBarrier& b) {
    asm volatile("s_waitcnt vmcnt(0)" ::: "memory");
    __syncthreads();
    if (threadIdx.x == 0) {
        unsigned* bar = b.bar;
        __builtin_amdgcn_s_waitcnt(0);
        unsigned nloc = b.st[0], nx = b.st[1];
        if (nloc == 0u) { xcd_barrier_complete(bar, b.x, nloc, nx); b.st[0] = nloc; b.st[1] = nx; }
        const unsigned old = xb_add(&bar[XB_XSUB(b.x)], 1u);
        const unsigned gen = old / nloc;
        if (old + 1u == (gen + 1u) * nloc) {
            __builtin_amdgcn_fence(__ATOMIC_RELEASE, "agent");
            asm volatile("s_waitcnt vmcnt(0)" ::: "memory");
            const unsigned og = xb_add(&bar[XB_TOP], 1u);
            const unsigned tg = og / nx;
            if (og + 1u == (tg + 1u) * nx) xb_add(&bar[XB_TOPGEN], 1u);
            else XB_SPIN(xb_ld(&bar[XB_TOPGEN]) == tg, bar);
            __builtin_amdgcn_fence(__ATOMIC_ACQUIRE, "agent");
            xb_add(&bar[XB_XGEN(b.x)], 1u);
            asm volatile("s_waitcnt vmcnt(0)" ::: "memory");
        } else {
            XB_SPIN(xb_ld(&bar[XB_XGEN(b.x)]) == gen, bar);
            __builtin_amdgcn_fence(__ATOMIC_ACQUIRE, "agent");
            asm volatile("s_waitcnt vmcnt(0)" ::: "memory");
        }
    }
    __syncthreads();
}

__global__ void __launch_bounds__(NTHREADS) hymba_fwd(Ptrs P) {
    extern __shared__ __attribute__((aligned(1024))) unsigned char lds_raw[];
    LAS unsigned char* lds = (LAS unsigned char*)lds_raw;
    cg::grid_group grid = cg::this_grid();
    const int lane = threadIdx.x & 63, wave = __builtin_amdgcn_readfirstlane(threadIdx.x >> 6);
    const int lo = P.ph_lo, hi = P.ph_hi;
    if (lo < 0) grid.sync();
    volatile LAS unsigned* bar_st = (volatile LAS unsigned*)(lds + 131072 + 1024);
    if (threadIdx.x < 2) bar_st[threadIdx.x] = 0u;
    __syncthreads();
    XcdBarrier bar = xcd_barrier_post((unsigned*)(P.ws + WS_CTL), bar_st);
#ifndef PHMASK
#define PHMASK 31
#endif
#define IN(k) (((PHMASK >> (k)) & 1) && lo <= (k) && (k) < hi)
#define SEAM(k) do { if (IN(k) && IN((k) + 1)) xcd_barrier(bar); } while (0)
    if (IN(0)) for (int rep = 0; rep < REP0; ++rep) phase0(P, lds, wave, lane);
    SEAM(0);
    if (IN(1)) for (int rep = 0; rep < REP1; ++rep) phase1(P, lds, wave, lane);
    SEAM(1);
    if (IN(2)) {
        __syncthreads();
        pg8::Gemm g{(const bf16_t*)(P.ws + WS_H), (const bf16_t*)(P.ws + WS_WIN), MROWS, 3328, 1024};
        pg8::StaticOrder S; S.init(MROWS, 3328, gridDim.x, (int)blockIdx.x, WGM_G1);
        pg8::EpiProj E{(bf16_t*)(P.ws + WS_PROJ), (const float*)(P.ws + WS_ROPE), P.q_norm_a, P.k_norm_a, P.q_norm_b, P.k_norm_b};
        pg8::gemm_phase<pg8::EpiProj, pg8::StaticOrder, true, true>(lds, g, S, E);
#if REP2 == 2
        __syncthreads();
        pg8::gemm_phase<pg8::EpiProj, pg8::StaticOrder, true, true>(lds, g, S, E);
#endif
    }
    SEAM(2);
    if (IN(3)) { __syncthreads(); phase3(P, lds); }
    SEAM(3);
    if (IN(4)) {
        __syncthreads();
        pg8::Gemm g{(const bf16_t*)(P.ws + WS_Y), (const bf16_t*)(P.ws + WS_WOUT), MROWS, 1024, 1024};
        pg8::StaticOrder S; S.init(MROWS, 1024, gridDim.x, (int)blockIdx.x, WGM_G2);
        pg8::EpiOut E{P.x, P.out, (const float*)(P.ws + WS_MOD) + 2048};
        pg8::gemm_phase<pg8::EpiOut, pg8::StaticOrder, true, true>(lds, g, S, E);
#if REP4 == 2
        __syncthreads();
        pg8::gemm_phase<pg8::EpiOut, pg8::StaticOrder, true, true>(lds, g, S, E);
#endif
    }
#undef IN
#undef SEAM
}

#ifndef MK_N_LAUNCHES
#define MK_N_LAUNCHES 1
#endif

extern "C" void kernel_launch(void* const* d_in, const int* in_sizes, int n_in, void* d_out, int out_size, void* d_ws, size_t ws_size, hipStream_t stream) {
    static int grid = 0;
    if (grid == 0) {
        if (n_in != 18 || ws_size < WS_END) { fprintf(stderr, "kernel_launch: unexpected n_in %d / ws_size %zu\n", n_in, ws_size); grid = -1; return; }
        int dev = 0, cus = 0, per_cu = 0;
        hipGetDevice(&dev);
        hipDeviceGetAttribute(&cus, hipDeviceAttributeMultiprocessorCount, dev);
        if (hipFuncSetAttribute((const void*)hymba_fwd, hipFuncAttributeMaxDynamicSharedMemorySize, LDS_BYTES) != hipSuccess) { fprintf(stderr, "kernel_launch: hipFuncSetAttribute failed\n"); grid = -1; return; }
        if (hipOccupancyMaxActiveBlocksPerMultiprocessor(&per_cu, (const void*)hymba_fwd, NTHREADS, LDS_BYTES) != hipSuccess || per_cu < 1) { fprintf(stderr, "kernel_launch: occupancy query says %d blocks/CU\n", per_cu); (void)hipGetLastError(); grid = -1; return; }
        grid = cus * per_cu;
        if (grid > 256) grid = 256;
    }
    if (grid < 0) return;
    if (hipMemsetAsync((char*)d_ws + WS_CTL, 0, CTL_BYTES, stream) != hipSuccess) { fprintf(stderr, "kernel_launch: memset of the barrier words failed\n"); return; }
    Ptrs p{};
    p.x = (const float*)d_in[0]; p.c = (const float*)d_in[1]; p.positions = (const int*)d_in[2]; p.w_ada = (const float*)d_in[3]; p.b_ada = (const float*)d_in[4];
    p.norm_gain = (const float*)d_in[5]; p.w_in = (const float*)d_in[6]; p.q_norm_a = (const float*)d_in[7]; p.k_norm_a = (const float*)d_in[8]; p.sink_a = (const float*)d_in[9];
    p.q_norm_b = (const float*)d_in[10]; p.k_norm_b = (const float*)d_in[11]; p.lq1 = (const float*)d_in[12]; p.lk1 = (const float*)d_in[13]; p.lq2 = (const float*)d_in[14];
    p.lk2 = (const float*)d_in[15]; p.subln = (const float*)d_in[16]; p.w_out = (const float*)d_in[17];
    p.out = (float*)d_out; p.ws = (unsigned char*)d_ws;
#if MK_N_LAUNCHES == 1
    p.ph_lo = 0; p.ph_hi = 5;
    void* args[] = {&p};
    hipError_t e = hipLaunchCooperativeKernel((const void*)hymba_fwd, dim3(grid), dim3(NTHREADS), args, LDS_BYTES, stream);
    if (e != hipSuccess) fprintf(stderr, "cooperative launch failed: %s (grid %d)\n", hipGetErrorString(e), grid);
#else
    for (int k = 0; k < 5; ++k) { p.ph_lo = k; p.ph_hi = k + 1; hipLaunchKernelGGL(hymba_fwd, dim3(grid), dim3(NTHREADS), LDS_BYTES, stream, p); }
#endif
}
```

```cpp
#include <hip/hip_runtime.h>
#include <hip/hip_cooperative_groups.h>
#include <cstdio>
#include <cstdint>
namespace cg = cooperative_groups;
#ifndef WGM_G1
#define WGM_G1 4
#endif
#ifndef WGM_G2
#define WGM_G2 4
#endif
#ifndef REP0
#define REP0 1
#endif
#ifndef REP1
#define REP1 1
#endif
#ifndef REP2
#define REP2 1
#endif
#ifndef REP3A
#define REP3A 1
#endif
#ifndef REP3B
#define REP3B 1
#endif
#ifndef REP4
#define REP4 1
#endif

namespace pg8 {
#define PG8_LAS __attribute__((address_space(3)))
typedef unsigned short bf16_t;
typedef short bf16x8 __attribute__((ext_vector_type(8)));
typedef float f32x4 __attribute__((ext_vector_type(4)));
typedef unsigned u32x4 __attribute__((ext_vector_type(4)));
constexpr int BM = 256, BK = 64, HALF = 128, HTB = HALF * BK * 2  , STAGE_BYTES = 8 * HTB, NXCD = 8;

__host__ __device__ __forceinline__ int lds_byte(int r, int c) { const int st = (r >> 4) * 2 + (c >> 5), rr = r & 15, cc = c & 31, ob = rr * 64 + cc * 2; return st * 1024 + (ob ^ (((ob >> 9) & 1) << 5)); }
__host__ __device__ __forceinline__ void stage_rc(int b, int& R, int& C) { const int st = b / 1024, sb = b % 1024, swz = sb ^ (((sb >> 9) & 1) << 5); R = (st >> 1) * 16 + swz / 64; C = (st & 1) * 32 + (swz % 64) / 2; }
__host__ __device__ __forceinline__ int perm32(int rho) { const int n = rho >> 4, i = rho & 15; return 8 * (i >> 2) + 4 * n + (i & 3); }

struct Unit { int pm, pn; };
struct Gemm { const bf16_t* A; const bf16_t* Bt; int M, N, K; };

struct StaticOrder {
    int nM, nN, nwg, G, c, WGM;
    __host__ __device__ void init(int M, int N, int G_, int c_, int wgm_ = 8) { nM = M / BM; nN = N / BM; nwg = nM * nN; G = G_; c = c_; WGM = wgm_; }
    __host__ __device__ bool next(int i, Unit& u) const {
        const long L = (long)i * G + c; if (L >= nwg) return false;
        int wgid = (int)L; { const int q = nwg / NXCD, r = nwg % NXCD, xcd = wgid % NXCD, off = wgid / NXCD; wgid = (xcd < r ? xcd * (q + 1) : r * (q + 1) + (xcd - r) * q) + off; }
        const int nig = WGM * nN, gid = wgid / nig, fm = gid * WGM, gsz = (nM - fm) < WGM ? (nM - fm) : WGM;
        u.pm = fm + ((wgid % nig) % gsz); u.pn = (wgid % nig) / gsz; return true;
    }
    __device__ __forceinline__ void a_ready(const Unit&) const {}
    __device__ __forceinline__ void done(const Unit&) const {}
};

typedef float f32x2 __attribute__((ext_vector_type(2)));
typedef __bf16 bf16x2_t __attribute__((ext_vector_type(2)));
__device__ __forceinline__ unsigned cvt_pk_bf16(float lo, float hi) { f32x2 v = {lo, hi}; bf16x2_t b = __builtin_convertvector(v, bf16x2_t); return __builtin_bit_cast(unsigned, b); }

constexpr int PROJ_W = 3328;
constexpr float QSCALE = 0.125f * 1.4426950408889634f;
constexpr float RMS_EPS = 1e-6f;

struct EpiProj {
    static constexpr bool PERM = true, AFTER_DRAIN = false;
    bf16_t* O; const float* rope; const float *gqa, *gka, *gqb, *gkb;
    __device__ __forceinline__ void operator()(const f32x4 (&acc)[2][2][4][2], const Unit& u, int wr, int wc, int fr, int fq) const {
        const int colh = u.pn * 256 + wc * 64;
        int mode; const float* gain = gqa; float osc = 1.f;
        if (colh < 512) { mode = 1; gain = gqa; osc = QSCALE; }
        else if (colh < 640) { mode = 1; gain = gka; }
        else if (colh < 768) mode = 0;
        else if (colh < 1280) mode = 2;
        else if (colh < 1792) { mode = 1; gain = gqb; osc = QSCALE; }
        else if (colh < 2304) { mode = 1; gain = gkb; }
        else if (colh < 2816) mode = 0;
        else mode = 2;
        const int row0 = u.pm * BM + wr * 64 + fr;
        if (mode == 1) {
            f32x4 g[2][2];
#pragma unroll
            for (int bj = 0; bj < 2; ++bj)
#pragma unroll
                for (int n = 0; n < 2; ++n) g[bj][n] = *(const f32x4*)(gain + 32 * bj + 8 * fq + 4 * n) * osc;
            f32x4 rc[4], rn[4];
#define ROPE_LOAD(dst, g_) do { const float* rp_ = rope + (size_t)(row0 + ((g_) >> 2) * HALF + ((g_) & 3) * 16) * 64 + 8 * fq; \
                dst[0] = *(const f32x4*)(rp_); dst[1] = *(const f32x4*)(rp_ + 4); dst[2] = *(const f32x4*)(rp_ + 32); dst[3] = *(const f32x4*)(rp_ + 36); } while (0)
            ROPE_LOAD(rc, 0);
#pragma unroll
            for (int gi = 0; gi < 8; ++gi) {
                const int ai = gi >> 2, m = gi & 3;
                if (gi < 7) ROPE_LOAD(rn, gi + 1);
                const int row = row0 + ai * HALF + m * 16;
                const f32x4 c0 = rc[0], c1 = rc[1], s0 = rc[2], s1 = rc[3];
                float ss = 0.f;
#pragma unroll
                for (int bj = 0; bj < 2; ++bj)
#pragma unroll
                    for (int n = 0; n < 2; ++n) { const f32x4 v = acc[ai][bj][m][n]; ss += (v[0] * v[0] + v[1] * v[1]) + (v[2] * v[2] + v[3] * v[3]); }
                ss += __shfl_xor(ss, 16); ss += __shfl_xor(ss, 32);
                const float rstd = rsqrtf(ss * (1.0f / 64.0f) + RMS_EPS);
                const f32x4 a0 = acc[ai][0][m][0] * rstd * g[0][0], a1 = acc[ai][0][m][1] * rstd * g[0][1];
                const f32x4 b0 = acc[ai][1][m][0] * rstd * g[1][0], b1 = acc[ai][1][m][1] * rstd * g[1][1];
                const f32x4 o00 = a0 * c0 - b0 * s0, o01 = a1 * c1 - b1 * s1, o10 = b0 * c0 + a0 * s0, o11 = b1 * c1 + a1 * s1;
                bf16_t* op = O + (size_t)row * PROJ_W + colh + 8 * fq;
                u32x4 w; w.x = cvt_pk_bf16(o00[0], o00[1]); w.y = cvt_pk_bf16(o00[2], o00[3]); w.z = cvt_pk_bf16(o01[0], o01[1]); w.w = cvt_pk_bf16(o01[2], o01[3]);
                *(u32x4*)op = w;
                w.x = cvt_pk_bf16(o10[0], o10[1]); w.y = cvt_pk_bf16(o10[2], o10[3]); w.z = cvt_pk_bf16(o11[0], o11[1]); w.w = cvt_pk_bf16(o11[2], o11[3]);
                *(u32x4*)(op + 32) = w;
#pragma unroll
                for (int k = 0; k < 4; ++k) rc[k] = rn[k];
            }
#undef ROPE_LOAD
        } else if (mode == 2) {
#pragma unroll
            for (int ai = 0; ai < 2; ++ai)
#pragma unroll
                for (int m = 0; m < 4; ++m) {
                    const int row = row0 + ai * HALF + m * 16;
                    bf16_t* op = O + (size_t)row * PROJ_W + colh + 8 * fq;
#pragma unroll
                    for (int bj = 0; bj < 2; ++bj) {
                        f32x4 v0 = acc[ai][bj][m][0], v1 = acc[ai][bj][m][1];
#pragma unroll
                        for (int j = 0; j < 4; ++j) { v0[j] = v0[j] * __builtin_amdgcn_rcpf(1.0f + __builtin_amdgcn_exp2f(-1.4426950408889634f * v0[j])); v1[j] = v1[j] * __builtin_amdgcn_rcpf(1.0f + __builtin_amdgcn_exp2f(-1.4426950408889634f * v1[j])); }
                        u32x4 w; w.x = cvt_pk_bf16(v0[0], v0[1]); w.y = cvt_pk_bf16(v0[2], v0[3]); w.z = cvt_pk_bf16(v1[0], v1[1]); w.w = cvt_pk_bf16(v1[2], v1[3]);
                        *(u32x4*)(op + 32 * bj) = w;
                    }
                }
        } else {
#pragma unroll
            for (int ai = 0; ai < 2; ++ai)
#pragma unroll
                for (int m = 0; m < 4; ++m) {
                    const int row = row0 + ai * HALF + m * 16;
                    bf16_t* op = O + (size_t)row * PROJ_W + colh + 8 * fq;
#pragma unroll
                    for (int bj = 0; bj < 2; ++bj) {
                        const f32x4 v0 = acc[ai][bj][m][0], v1 = acc[ai][bj][m][1];
                        u32x4 w; w.x = cvt_pk_bf16(v0[0], v0[1]); w.y = cvt_pk_bf16(v0[2], v0[3]); w.z = cvt_pk_bf16(v1[0], v1[1]); w.w = cvt_pk_bf16(v1[2], v1[3]);
                        *(u32x4*)(op + 32 * bj) = w;
                    }
                }
        }
    }
};

struct EpiOut {
    static constexpr bool PERM = true, AFTER_DRAIN = false;
    const float* __restrict__ x; float* __restrict__ out; const float* __restrict__ gate;
    __device__ __forceinline__ void operator()(const f32x4 (&acc)[2][2][4][2], const Unit& u, int wr, int wc, int fr, int fq) const {
        const int row0 = u.pm * BM + wr * 64 + fr, col0 = u.pn * BM + wc * 32 + 8 * fq;
        const float* gp = gate + (size_t)(u.pm >> 3) * 3072 + col0;
        f32x4 gv[2][2];
#pragma unroll
        for (int bj = 0; bj < 2; ++bj)
#pragma unroll
            for (int n = 0; n < 2; ++n) gv[bj][n] = *(const f32x4*)(gp + bj * HALF + 4 * n);
        f32x4 xc[2][2][2], xn[2][2][2];
#define EPI_LOAD(dst, b) do { _Pragma("unroll") for (int mm = 0; mm < 2; ++mm) { const size_t off_ = (size_t)(row0 + ((b) >> 1) * HALF + (2 * ((b) & 1) + mm) * 16) * 1024 + col0; \
            _Pragma("unroll") for (int bj = 0; bj < 2; ++bj) _Pragma("unroll") for (int n = 0; n < 2; ++n) dst[mm][bj][n] = __builtin_nontemporal_load((const f32x4*)(x + off_ + bj * HALF + 4 * n)); } } while (0)
        EPI_LOAD(xc, 0);
#pragma unroll
        for (int b = 0; b < 4; ++b) {
            if (b < 3) EPI_LOAD(xn, b + 1);
#pragma unroll
            for (int mm = 0; mm < 2; ++mm) {
                const size_t off = (size_t)(row0 + (b >> 1) * HALF + (2 * (b & 1) + mm) * 16) * 1024 + col0;
#pragma unroll
                for (int bj = 0; bj < 2; ++bj)
#pragma unroll
                    for (int n = 0; n < 2; ++n) *(f32x4*)(out + off + bj * HALF + 4 * n) = xc[mm][bj][n] + gv[bj][n] * acc[b >> 1][bj][2 * (b & 1) + mm][n];
            }
#pragma unroll
            for (int mm = 0; mm < 2; ++mm)
#pragma unroll
                for (int bj = 0; bj < 2; ++bj)
#pragma unroll
                    for (int n = 0; n < 2; ++n) xc[mm][bj][n] = xn[mm][bj][n];
        }
#undef EPI_LOAD
    }
};

template <class Epi, class Sched, bool ALIGN_EPI = false, bool SP2 = false>
__device__ __forceinline__ void gemm_phase(PG8_LAS unsigned char* lds, const Gemm g, const Sched& S, const Epi& E) {
    const int tid = threadIdx.x, wid = __builtin_amdgcn_readfirstlane(tid >> 6), lane = tid & 63, wr = wid >> 2, wc = wid & 3, fr = lane & 15, fq = lane >> 4;
    const int K = g.K, nt = K / BK;
    unsigned voffA[2], voffB[2];
#pragma unroll
    for (int i = 0; i < 2; ++i) { int R, C; stage_rc(tid * 16 + i * 8192, R, C); const int Rb = Epi::PERM ? ((R & ~31) + perm32(R & 31)) : R;
        voffA[i] = (unsigned)(R * K + C) * 2u; voffB[i] = (unsigned)(Rb * K + C) * 2u; }
    const size_t kstep = (size_t)(BK * 2);
    const size_t hstep = (size_t)HALF * K * 2;
    const size_t tstep = 2 * hstep;
    const unsigned ldsw = (unsigned)wid * 1024u;
    const int aoff = lds_byte(wr * 64 + fr, fq * 8), boff = lds_byte(wc * 32 + fr, fq * 8);
#define PG8_SA(b, h) (((b) * 2 + (h)) * HTB)
#define PG8_SB(b, h) ((4 + (b) * 2 + (h)) * HTB)
#define PG8_STAGE(bufoff, gbase, voff) do { _Pragma("unroll") for (int _i = 0; _i < 2; ++_i) \
        __builtin_amdgcn_global_load_lds((const unsigned*)((const char*)(gbase) + (voff)[_i]), (PG8_LAS unsigned*)(lds + (bufoff) + ldsw + _i * 8192), 16, 0, 0); } while (0)
#define PG8_LDA(dst, b, h) do { _Pragma("unroll") for (int m = 0; m < 4; ++m) _Pragma("unroll") for (int k = 0; k < 2; ++k) dst[m][k] = *(const PG8_LAS bf16x8*)(lds + PG8_SA(b, h) + aoff + m * 2048 + k * 1024); } while (0)
#define PG8_LDB(dst, b, h) do { _Pragma("unroll") for (int n = 0; n < 2; ++n) _Pragma("unroll") for (int k = 0; k < 2; ++k) dst[n][k] = *(const PG8_LAS bf16x8*)(lds + PG8_SB(b, h) + boff + n * 2048 + k * 1024); } while (0)
#define PG8_MMA(ai, bj, At, Bt) do { __builtin_amdgcn_s_setprio(1); _Pragma("unroll") for (int m = 0; m < 4; ++m) _Pragma("unroll") for (int n = 0; n < 2; ++n) _Pragma("unroll") for (int k = 0; k < 2; ++k) \
        acc[ai][bj][m][n] = __builtin_amdgcn_mfma_f32_16x16x32_bf16(Bt[n][k], At[m][k], acc[ai][bj][m][n], 0, 0, 0); __builtin_amdgcn_s_setprio(0); } while (0)
#define PG8_WAIT_V(n) asm volatile("s_waitcnt vmcnt(" #n ")" ::: "memory")
#define PG8_WAIT_L(n) asm volatile("s_waitcnt lgkmcnt(" #n ")" ::: "memory")
#define PG8_BAR __builtin_amdgcn_s_barrier()
#define PG8_SCHED __builtin_amdgcn_sched_barrier(0)
    Unit cur, nxt; int ui = 0;
    if (!S.next(0, cur)) return;
    f32x4 acc[2][2][4][2];
#pragma unroll
    for (int a = 0; a < 2; ++a)
#pragma unroll
        for (int b = 0; b < 2; ++b)
#pragma unroll
            for (int m = 0; m < 4; ++m)
#pragma unroll
                for (int n = 0; n < 2; ++n) acc[a][b][m][n] = (f32x4){0.f, 0.f, 0.f, 0.f};
    bf16x8 At[4][2], B0[2][2], B1[2][2];
    const char* cA = (const char*)g.A + (size_t)cur.pm * tstep; const char* cB = (const char*)g.Bt + (size_t)cur.pn * tstep;
    S.a_ready(cur);
    if constexpr (SP2) {
        PG8_STAGE(PG8_SB(0, 0), cB, voffB); PG8_STAGE(PG8_SB(0, 1), cB + hstep, voffB); PG8_STAGE(PG8_SA(0, 0), cA, voffA); PG8_STAGE(PG8_SA(0, 1), cA + hstep, voffA);
        if (wr == 1) PG8_BAR;
        PG8_WAIT_V(2); PG8_BAR;
        PG8_STAGE(PG8_SB(1, 0), cB + kstep, voffB); PG8_STAGE(PG8_SA(1, 0), cA + kstep, voffA); PG8_STAGE(PG8_SB(1, 1), cB + hstep + kstep, voffB);
        PG8_WAIT_V(6); PG8_BAR;
    } else {
        PG8_STAGE(PG8_SB(0, 0), cB, voffB); PG8_STAGE(PG8_SA(0, 0), cA, voffA); PG8_STAGE(PG8_SB(0, 1), cB + hstep, voffB); PG8_STAGE(PG8_SA(0, 1), cA + hstep, voffA);
        if (wr == 1) PG8_BAR;
        PG8_WAIT_V(4); PG8_BAR;
        PG8_STAGE(PG8_SB(1, 0), cB + kstep, voffB); PG8_STAGE(PG8_SA(1, 0), cA + kstep, voffA); PG8_STAGE(PG8_SB(1, 1), cB + hstep + kstep, voffB);
        PG8_WAIT_V(6); PG8_BAR;
    }
    for (;;) {
        const bool has_next = S.next(ui + 1, nxt);
        const char* nA = has_next ? (const char*)g.A + (size_t)nxt.pm * tstep : cA; const char* nB = has_next ? (const char*)g.Bt + (size_t)nxt.pn * tstep : cB;
        for (int t = 0; t < nt; t += 2) {
            const bool last = (t == nt - 2);
            const char* a1 = cA + (size_t)(t + 1) * kstep;
            const char* a2 = last ? nA : cA + (size_t)(t + 2) * kstep; const char* b2 = last ? nB : cB + (size_t)(t + 2) * kstep;
            const char* a3 = a2 + kstep; const char* b3 = b2 + kstep;
            if (last && has_next) S.a_ready(nxt);
            if constexpr (SP2) {
            PG8_LDB(B0, 0, 0); PG8_LDB(B1, 0, 1); PG8_SCHED; PG8_LDA(At, 0, 0); PG8_STAGE(PG8_SA(1, 1), a1 + hstep, voffA);
            PG8_WAIT_V(8); PG8_WAIT_L(0); PG8_BAR; PG8_MMA(0, 0, At, B0); PG8_MMA(0, 1, At, B1); PG8_BAR; PG8_SCHED;
            PG8_LDA(At, 0, 1); PG8_STAGE(PG8_SB(0, 0), b2, voffB); PG8_STAGE(PG8_SB(0, 1), b2 + hstep, voffB); PG8_STAGE(PG8_SA(0, 0), a2, voffA);
            PG8_WAIT_V(8); PG8_WAIT_L(0); PG8_BAR; PG8_MMA(1, 0, At, B0); PG8_MMA(1, 1, At, B1); PG8_BAR; PG8_SCHED;
            PG8_LDB(B0, 1, 0); PG8_LDB(B1, 1, 1); PG8_SCHED; PG8_LDA(At, 1, 0); PG8_STAGE(PG8_SA(0, 1), a2 + hstep, voffA);
            PG8_WAIT_V(8); PG8_WAIT_L(0); PG8_BAR; PG8_MMA(0, 0, At, B0); PG8_MMA(0, 1, At, B1); PG8_BAR; PG8_SCHED;
            PG8_LDA(At, 1, 1); PG8_STAGE(PG8_SB(1, 0), b3, voffB); PG8_STAGE(PG8_SB(1, 1), b3 + hstep, voffB); PG8_STAGE(PG8_SA(1, 0), a3, voffA);
            PG8_WAIT_V(8); PG8_WAIT_L(0); PG8_BAR; PG8_MMA(1, 0, At, B0); PG8_MMA(1, 1, At, B1); PG8_BAR; PG8_SCHED;
            } else {
            PG8_LDB(B0, 0, 0); PG8_SCHED; PG8_LDA(At, 0, 0); PG8_STAGE(PG8_SA(1, 1), a1 + hstep, voffA);
            PG8_WAIT_L(8); PG8_BAR; PG8_WAIT_L(0); PG8_MMA(0, 0, At, B0); PG8_BAR; PG8_SCHED;
            PG8_LDB(B1, 0, 1); PG8_STAGE(PG8_SB(0, 0), b2, voffB);
            PG8_BAR; PG8_WAIT_L(0); PG8_MMA(0, 1, At, B1); PG8_BAR;
            PG8_LDA(At, 0, 1); PG8_STAGE(PG8_SA(0, 0), a2, voffA);
            PG8_BAR; PG8_WAIT_L(0); PG8_MMA(1, 0, At, B0); PG8_BAR; PG8_SCHED;
            PG8_STAGE(PG8_SB(0, 1), b2 + hstep, voffB);
            PG8_WAIT_V(6); PG8_BAR; PG8_MMA(1, 1, At, B1); PG8_BAR;
            PG8_LDB(B0, 1, 0); PG8_SCHED; PG8_LDA(At, 1, 0); PG8_STAGE(PG8_SA(0, 1), a2 + hstep, voffA);
            PG8_WAIT_L(8); PG8_BAR; PG8_WAIT_L(0); PG8_MMA(0, 0, At, B0); PG8_BAR; PG8_SCHED;
            PG8_LDB(B1, 1, 1); PG8_STAGE(PG8_SB(1, 0), b3, voffB);
            PG8_BAR; PG8_WAIT_L(0); PG8_MMA(0, 1, At, B1); PG8_BAR;
            PG8_LDA(At, 1, 1); PG8_STAGE(PG8_SA(1, 0), a3, voffA);
            PG8_BAR; PG8_WAIT_L(0); PG8_MMA(1, 0, At, B0); PG8_BAR; PG8_SCHED;
            PG8_STAGE(PG8_SB(1, 1), b3 + hstep, voffB);
            PG8_WAIT_V(6); PG8_BAR; PG8_MMA(1, 1, At, B1); PG8_BAR;
            }
        }
        if constexpr (ALIGN_EPI) { if (wr == 0) PG8_BAR; }
        if constexpr (!Epi::AFTER_DRAIN) { E(acc, cur, wr, wc, fr, fq); S.done(cur); }
        if (!has_next) break;
#pragma unroll
        for (int a = 0; a < 2; ++a)
#pragma unroll
            for (int b = 0; b < 2; ++b)
#pragma unroll
                for (int m = 0; m < 4; ++m)
#pragma unroll
                    for (int n = 0; n < 2; ++n) acc[a][b][m][n] = (f32x4){0.f, 0.f, 0.f, 0.f};
        cur = nxt; cA = nA; cB = nB; ++ui;
        if constexpr (ALIGN_EPI) { if (wr == 1) PG8_BAR; }
    }
    PG8_WAIT_V(0);
    if constexpr (!ALIGN_EPI) { if (wr == 0) PG8_BAR; }
    PG8_BAR;
    if constexpr (Epi::AFTER_DRAIN) { E.fused(acc, cur, wr, wc, fr, fq, lds, wid, lane); S.done(cur); }
#undef PG8_SA
#undef PG8_SB
#undef PG8_STAGE
#undef PG8_LDA
#undef PG8_LDB
#undef PG8_MMA
#undef PG8_WAIT_V
#undef PG8_WAIT_L
#undef PG8_BAR
#undef PG8_SCHED
}
}

constexpr int D_MODEL = 1024, BATCH = 32, SEQ = 2048, MROWS = BATCH * SEQ;
constexpr int NWAVES = 8, NTHREADS = 512;
constexpr float LOG2E = 1.4426950408889634f;
constexpr float RMS_EPS_ = 1e-6f;
constexpr float LAMBDA_INIT = 0.2f;
constexpr int C_QA = 0, C_KA = 512, C_VA = 640, C_GA = 768, C_QB = 1280, C_KB = 1792, C_VB = 2304, C_GB = 2816;

#define LAS __attribute__((address_space(3)))
typedef unsigned short bf16_t;
typedef short bf16x8 __attribute__((ext_vector_type(8)));
typedef short s16x4 __attribute__((ext_vector_type(4)));
typedef float f32x4 __attribute__((ext_vector_type(4)));
typedef float f32x16 __attribute__((ext_vector_type(16)));
typedef unsigned u32x4 __attribute__((ext_vector_type(4)));
typedef unsigned u32x2 __attribute__((ext_vector_type(2)));
using pg8::cvt_pk_bf16; using pg8::PROJ_W;

constexpr size_t MiB = 1u << 20;
constexpr size_t WS_MODP = 0;
constexpr size_t WS_CTL = 12 * MiB, CTL_BYTES = 16384;
constexpr size_t WS_MOD = 8 * MiB;
constexpr size_t WS_WIN = 16 * MiB;
constexpr size_t WS_WOUT = 24 * MiB;
constexpr size_t WS_ROPE = 32 * MiB;
constexpr size_t WS_H = 64 * MiB;
constexpr size_t WS_Y = WS_H;
constexpr size_t WS_PROJ = 192 * MiB;
constexpr size_t WS_END = WS_PROJ + (size_t)MROWS * 3328 * 2;

constexpr int LDS_BYTES = 147456;

__device__ __forceinline__ float wave_sum(float v) {
#pragma unroll
    for (int o = 1; o < 64; o <<= 1) v += __shfl_xor(v, o);
    return v;
}
__device__ __forceinline__ unsigned f2bf(float f) { unsigned u = __builtin_bit_cast(unsigned, f); return (u + 0x7fffu + ((u >> 16) & 1u)) >> 16; }
__device__ __forceinline__ unsigned pk2(float lo, float hi) { return cvt_pk_bf16(lo, hi); }
__device__ __forceinline__ float bf_lo(unsigned w) { return __builtin_bit_cast(float, w << 16); }
__device__ __forceinline__ float bf_hi(unsigned w) { return __builtin_bit_cast(float, w & 0xffff0000u); }

__device__ __forceinline__ void p0_transpose_item(const float* W, int K, int N, bf16_t* WT, bool headperm, LAS float* scr, int item, int lane) {
    const int nblk = N / 32, kb = item / nblk, nb = item % nblk, k0 = 64 * kb, n0 = 32 * nb;
    const int prow0 = headperm ? ((n0 & ~255) + 128 * ((n0 >> 5) & 1) + 32 * ((n0 >> 6) & 3)) : n0;
#pragma unroll 8
    for (int i = 0; i < 32; ++i) { const int kk = 2 * i + (lane >> 5); scr[kk * 33 + (lane & 31)] = W[(size_t)(k0 + kk) * N + n0 + (lane & 31)]; }
    __builtin_amdgcn_s_waitcnt(0xc07f); asm volatile("s_waitcnt lgkmcnt(0)" ::: "memory");
    const int c = lane & 7;
#pragma unroll
    for (int j = 0; j < 4; ++j) { const int n = (lane >> 3) + 8 * j; const LAS float* s = scr + (8 * c) * 33 + n;
        u32x4 o; o.x = pk2(s[0 * 33], s[1 * 33]); o.y = pk2(s[2 * 33], s[3 * 33]); o.z = pk2(s[4 * 33], s[5 * 33]); o.w = pk2(s[6 * 33], s[7 * 33]);
        *(u32x4*)(WT + (size_t)(prow0 + n) * K + k0 + 8 * c) = o; }
    asm volatile("s_waitcnt lgkmcnt(0)" ::: "memory");
}

__device__ __forceinline__ void p0_mod_item(const float* c, const float* w_ada, float* modp, LAS float* scr, int item, int lane) {
    const int kc = item / 48, cgp = item % 48, k0 = kc * 64, n = cgp * 64 + lane;
    float w[64];
#pragma unroll
    for (int k = 0; k < 64; ++k) w[k] = w_ada[(size_t)(k0 + k) * 3072 + n];
    {
        const int b = lane & 31, kh = lane >> 5;
#pragma unroll 8
        for (int kk = 0; kk < 32; ++kk) { const int k = 2 * kk + kh; const float v = c[b * 1024 + k0 + k]; scr[k * 32 + b] = v / (1.0f + __expf(-v)); }
    }
    asm volatile("s_waitcnt lgkmcnt(0)" ::: "memory");
    float acc[32];
#pragma unroll
    for (int b = 0; b < 32; ++b) acc[b] = 0.f;
#pragma unroll
    for (int k = 0; k < 64; ++k) {
#pragma unroll
        for (int b4 = 0; b4 < 8; ++b4) { const f32x4 sv = *(const LAS f32x4*)(scr + k * 32 + 4 * b4); acc[4 * b4] += sv[0] * w[k]; acc[4 * b4 + 1] += sv[1] * w[k]; acc[4 * b4 + 2] += sv[2] * w[k]; acc[4 * b4 + 3] += sv[3] * w[k]; }
    }
#pragma unroll
    for (int b = 0; b < 32; ++b) modp[((size_t)kc * 32 + b) * 3072 + n] = acc[b];
    asm volatile("s_waitcnt lgkmcnt(0)" ::: "memory");
}

__device__ __forceinline__ void p0_rope(const int* positions, float* rope, int idx, float inv_freq) {
    const int r = idx >> 5, i = idx & 31;
    const float angf = (float)positions[r] * inv_freq;
    const double a = (double)angf;
    const double nq = rint(a * 0.63661977236758134308);
    const double rr = (a - nq * 1.57079632679489655800) - nq * 6.12323399573676603587e-17;
    const double r2 = rr * rr;
    const double sn = rr * (1.0 + r2 * (-1.0 / 6 + r2 * (1.0 / 120 + r2 * (-1.0 / 5040 + r2 * (1.0 / 362880 + r2 * (-1.0 / 39916800 + r2 * (1.0 / 6227020800.0)))))));
    const double cs = 1.0 + r2 * (-0.5 + r2 * (1.0 / 24 + r2 * (-1.0 / 720 + r2 * (1.0 / 40320 + r2 * (-1.0 / 3628800 + r2 * (1.0 / 479001600 + r2 * (-1.0 / 87178291200.0)))))));
    const int q = ((int)(long long)nq) & 3;
    const double s = (q == 0) ? sn : (q == 1) ? cs : (q == 2) ? -sn : -cs;
    const double cc = (q == 0) ? cs : (q == 1) ? -sn : (q == 2) ? -cs : sn;
    rope[(size_t)r * 64 + i] = (float)cc; rope[(size_t)r * 64 + 32 + i] = (float)s;
}

struct Ptrs {
    const float *x, *c; const int* positions; const float *w_ada, *b_ada, *norm_gain, *w_in, *q_norm_a, *k_norm_a, *sink_a, *q_norm_b, *k_norm_b, *lq1, *lk1, *lq2, *lk2, *subln, *w_out;
    float* out; unsigned char* ws; int ph_lo, ph_hi;
};

__device__ __forceinline__ void phase0(const Ptrs& P, LAS unsigned char* lds, int wave, int lane) {
    LAS float* scr = (LAS float*)(lds + wave * 16384);
    const int gw = blockIdx.x * NWAVES + wave, NGW = gridDim.x * NWAVES;
    constexpr int I_MOD = 16 * 48, I_IN = (1024 / 64) * (3328 / 32), I_OUT = (1024 / 64) * (1024 / 32);
    constexpr int NITEMS = I_MOD + I_IN + I_OUT;
    float* modp = (float*)(P.ws + WS_MODP);
    const int nmodw = (NGW >= 2 * I_MOD) ? I_MOD : 0;
    if (gw < nmodw) p0_mod_item(P.c, P.w_ada, modp, scr, gw, lane);
    else {
        for (int it = gw - nmodw + (nmodw ? I_MOD : 0); it < NITEMS; it += NGW - nmodw) {
            int r = it;
            if (r < I_MOD) { p0_mod_item(P.c, P.w_ada, modp, scr, r, lane); continue; } r -= I_MOD;
            if (r < I_IN) { p0_transpose_item(P.w_in, 1024, 3328, (bf16_t*)(P.ws + WS_WIN), true, scr, r, lane); continue; } r -= I_IN;
            p0_transpose_item(P.w_out, 1024, 1024, (bf16_t*)(P.ws + WS_WOUT), false, scr, r, lane);
        }
    }
    float* rope = (float*)(P.ws + WS_ROPE);
    const float inv_freq = 1.0f / powf(10000.0f, (float)(2 * (threadIdx.x & 31)) / 64.0f);
    for (int idx = blockIdx.x * NTHREADS + threadIdx.x; idx < MROWS * 32; idx += gridDim.x * NTHREADS) p0_rope(P.positions, rope, idx, inv_freq);
}

__device__ __forceinline__ void phase1(const Ptrs& P, LAS unsigned char* lds, int wave, int lane) {
    LAS float* sh_gs = (LAS float*)lds;
    LAS float* sh_sf = (LAS float*)(lds + 4096);
    const float* modp = (const float*)(P.ws + WS_MODP);
    float* mod = (float*)(P.ws + WS_MOD);
    bf16_t* H = (bf16_t*)(P.ws + WS_H);
    for (int t = blockIdx.x; t < MROWS / 256; t += gridDim.x) {
        const int b = t >> 3;
        __syncthreads();
        for (int n = threadIdx.x; n < 3072; n += NTHREADS) {
            if (n >= 2048 && (t & 7) != 0) break;
            float s = P.b_ada[n];
#pragma unroll
            for (int kc = 0; kc < 16; ++kc) s += modp[((size_t)kc * 32 + b) * 3072 + n];
            if (n < 1024) sh_sf[n] = s;
            else if (n < 2048) sh_gs[n - 1024] = P.norm_gain[n - 1024] * (1.0f + s);
            else mod[(size_t)b * 3072 + n] = s;
        }
        __syncthreads();
        f32x4 v[4][4], vn[4][4];
        {
            const f32x4* xr = (const f32x4*)(P.x + ((size_t)t * 256 + wave * 32) * 1024) + lane;
#pragma unroll
            for (int q = 0; q < 4; ++q)
#pragma unroll
                for (int j = 0; j < 4; ++j) v[q][j] = __builtin_nontemporal_load(xr + q * 256 + 64 * j);
        }
        for (int rr = 0; rr < 32; rr += 4) {
            const size_t row = (size_t)t * 256 + wave * 32 + rr;
            if (rr + 4 < 32) {
                const f32x4* xr = (const f32x4*)(P.x + (row + 4) * 1024) + lane;
#pragma unroll
                for (int q = 0; q < 4; ++q)
#pragma unroll
                    for (int j = 0; j < 4; ++j) vn[q][j] = __builtin_nontemporal_load(xr + q * 256 + 64 * j);
            }
            float s[4];
#pragma unroll
            for (int q = 0; q < 4; ++q) { s[q] = 0.f;
#pragma unroll
                for (int j = 0; j < 4; ++j) s[q] += (v[q][j].x * v[q][j].x + v[q][j].y * v[q][j].y) + (v[q][j].z * v[q][j].z + v[q][j].w * v[q][j].w); }
#pragma unroll
            for (int o = 1; o < 64; o <<= 1) {
#pragma unroll
                for (int q = 0; q < 4; ++q) s[q] += __shfl_xor(s[q], o); }
#pragma unroll
            for (int q = 0; q < 4; ++q) {
                const float rstd = rsqrtf(s[q] * (1.f / 1024) + RMS_EPS_);
                u32x2* o8 = (u32x2*)(H + (row + q) * 1024) + lane;
#pragma unroll
                for (int j = 0; j < 4; ++j) {
                    const f32x4 g = *(const LAS f32x4*)(sh_gs + 256 * j + 4 * lane), sf = *(const LAS f32x4*)(sh_sf + 256 * j + 4 * lane);
                    const f32x4 hv = v[q][j] * rstd * g + sf;
                    u32x2 w; w.x = pk2(hv.x, hv.y); w.y = pk2(hv.z, hv.w); o8[64 * j] = w;
                }
            }
#pragma unroll
            for (int q = 0; q < 4; ++q)
#pragma unroll
                for (int j = 0; j < 4; ++j) v[q][j] = vn[q][j];
        }
    }
}

__device__ __forceinline__ unsigned off_b(unsigned row, unsigned ch) { return 256u * row + 16u * (ch ^ (((row & 3) << 2) | ((row >> 2) & 3))); }
__device__ __forceinline__ int crow(int r, int hi) { return (r & 3) + 8 * (r >> 2) + 4 * hi; }
__device__ __forceinline__ s16x4 vtr(const LAS unsigned char* p) { typedef short v4i16_t __attribute__((ext_vector_type(4))); return __builtin_bit_cast(s16x4, __builtin_amdgcn_ds_read_tr16_b64_v4i16((LAS v4i16_t*)p)); }
#define MFMA32(a, b, c) __builtin_amdgcn_mfma_f32_32x32x16_bf16((a), (b), (c), 0, 0, 0)

typedef const LAS unsigned char* ldsp_t;
__device__ __forceinline__ ldsp_t lxor(ldsp_t p, unsigned c) { return (ldsp_t)((unsigned)(uintptr_t)p ^ c); }
template <int NEB, bool MASK, bool QLDS, int KCH0, int VCH0, int QCH0>
__device__ __forceinline__ void att_half(ldsp_t kaddr, ldsp_t vaddr, ldsp_t qaddr, const bf16x8 (&qf)[4], f32x16 (&o)[NEB], float& l, float negm, int hi, int dq0  ) {
    f32x16 s;
#pragma unroll
    for (int i = 0; i < 16; ++i) s[i] = negm;
#pragma unroll
    for (int ks = 0; ks < 4; ++ks) {
        const bf16x8 kf = *(const LAS bf16x8*)lxor(kaddr, 16u * (KCH0 + 2 * ks));
        bf16x8 qv;
        if (QLDS) qv = *(const LAS bf16x8*)lxor(qaddr, 16u * (QCH0 + 2 * ks)); else qv = qf[ks];
        s = MFMA32(kf, qv, s);
    }
    float sum = 0.f;
#pragma unroll
    for (int i = 0; i < 16; ++i) {
        float p = __builtin_amdgcn_exp2f(s[i]);
        if (MASK) { const int d = dq0 - crow(i, hi); p = (d <= 128 && d >= -128) ? p : 0.f; }
        s[i] = p; sum += p;
    }
    l += sum;
    u32x4 w0, w1;
    w0.x = cvt_pk_bf16(s[0], s[1]); w0.y = cvt_pk_bf16(s[2], s[3]); w0.z = cvt_pk_bf16(s[4], s[5]); w0.w = cvt_pk_bf16(s[6], s[7]);
    w1.x = cvt_pk_bf16(s[8], s[9]); w1.y = cvt_pk_bf16(s[10], s[11]); w1.z = cvt_pk_bf16(s[12], s[13]); w1.w = cvt_pk_bf16(s[14], s[15]);
    const bf16x8 pk0 = __builtin_bit_cast(bf16x8, w0), pk1 = __builtin_bit_cast(bf16x8, w1);
#pragma unroll
    for (int eb = 0; eb < NEB; ++eb) {
        const ldsp_t a0 = lxor(vaddr, 64u * (VCH0 / 4 + eb)), a1 = lxor(vaddr, (64u * (VCH0 / 4 + eb)) ^ 32u);
#pragma unroll
        for (int u = 0; u < 2; ++u) {
            const s16x4 lo = vtr(a0 + 4096 * u);
            const s16x4 hh = vtr(a1 + 4096 * u + 2048);
            const bf16x8 vf = (bf16x8){lo[0], lo[1], lo[2], lo[3], hh[0], hh[1], hh[2], hh[3]};
            o[eb] = MFMA32(vf, u == 0 ? pk0 : pk1, o[eb]);
        }
    }
}
__device__ __forceinline__ unsigned lane_kL(int r32, int hi) { const unsigned xk = ((r32 & 3) << 2) | ((r32 >> 2) & 3); return 256u * r32 + 16u * ((unsigned)hi ^ xk); }
__device__ __forceinline__ unsigned lane_vL(int lane, int hi) { const unsigned blk = (lane >> 4) & 1, q = (lane & 15) >> 2, p = lane & 3; return 256u * (4 * hi + q) + 64u * q + ((32u * blk + 16u * (p >> 1)) ^ (16u * hi)) + 8u * (p & 1); }

__device__ __forceinline__ void glds16(const void* gsrc, unsigned lds_dst) { unsigned keep;
    asm volatile("s_mov_b32 %0, m0\n\ts_mov_b32 m0, %2\n\ts_nop 0\n\tglobal_load_lds_dwordx4 %1, off\n\ts_mov_b32 m0, %0" : "=&s"(keep) : "v"(gsrc), "s"(lds_dst) : "memory"); }
__device__ __forceinline__ f32x16 qk_half(ldsp_t kaddr, const bf16x8 (&qf)[4], float negm) {
    f32x16 s;
#pragma unroll
    for (int i = 0; i < 16; ++i) s[i] = negm;
#pragma unroll
    for (int ks = 0; ks < 4; ++ks) { const bf16x8 kf = *(const LAS bf16x8*)lxor(kaddr, 32u * ks); s = MFMA32(kf, qf[ks], s); }
    return s;
}
__device__ __forceinline__ void exp_pack(f32x16& s, float& l, bf16x8& pk0, bf16x8& pk1) {
    float sum = 0.f;
#pragma unroll
    for (int i = 0; i < 16; ++i) { s[i] = __builtin_amdgcn_exp2f(s[i]); sum += s[i]; }
    l += sum;
    u32x4 w0, w1;
    w0.x = cvt_pk_bf16(s[0], s[1]); w0.y = cvt_pk_bf16(s[2], s[3]); w0.z = cvt_pk_bf16(s[4], s[5]); w0.w = cvt_pk_bf16(s[6], s[7]);
    w1.x = cvt_pk_bf16(s[8], s[9]); w1.y = cvt_pk_bf16(s[10], s[11]); w1.z = cvt_pk_bf16(s[12], s[13]); w1.w = cvt_pk_bf16(s[14], s[15]);
    pk0 = __builtin_bit_cast(bf16x8, w0); pk1 = __builtin_bit_cast(bf16x8, w1);
}
template <int NEB, int VB = 0>
__device__ __forceinline__ void pv_half(ldsp_t vaddr, const bf16x8 pk0, const bf16x8 pk1, f32x16 (&o)[NEB]) {
#pragma unroll
    for (int eb = 0; eb < NEB; ++eb) {
        const ldsp_t a0 = lxor(vaddr, 64u * (VB + eb)), a1 = lxor(vaddr, (64u * (VB + eb)) ^ 32u);
#pragma unroll
        for (int u = 0; u < 2; ++u) {
            const s16x4 lo = vtr(a0 + 4096 * u);
            const s16x4 hh = vtr(a1 + 4096 * u + 2048);
            const bf16x8 vf = (bf16x8){lo[0], lo[1], lo[2], lo[3], hh[0], hh[1], hh[2], hh[3]};
            o[eb] = MFMA32(vf, u == 0 ? pk0 : pk1, o[eb]);
        }
    }
}

__device__ __forceinline__ void attnB_stream(LAS unsigned char* lds, const bf16_t* proj, bf16_t* y, const float* subln, int u0, int ustride, int nunits, float negm, float lam) {
    const int tid = threadIdx.x, lane = tid & 63, wid = __builtin_amdgcn_readfirstlane(tid >> 6), r32 = lane & 31, hi = lane >> 5;
    const int c = wid >> 2, rg = wid & 3;
    const int img = wid >> 2;
    unsigned goff[4];
#pragma unroll
    for (int i = 0; i < 4; ++i) goff[i] = (unsigned)((16 * (wid & 3) + 4 * i + (lane >> 4)) * PROJ_W + 8 * ((lane & 15) ^ (((lane >> 4) << 2) | i))) * 2u;
    const unsigned dst0 = img * 16384 + (4 * (wid & 3)) * 1024;
    const unsigned ldsbase = (unsigned)(uintptr_t)lds;
#define UNIT_GSRC(u) ((const char*)(proj + (size_t)((u) >> 6) * SEQ * PROJ_W + (img ? C_VB : C_KB) + 128 * (((u) >> 4) & 3)))
#define DMA_TILE(gs0, t, bufoff) do { const char* gs_ = (gs0) + (size_t)(t) * (64 * PROJ_W * 2); _Pragma("unroll") for (int i_ = 0; i_ < 4; ++i_) \
        glds16(gs_ + goff[i_], (unsigned)__builtin_amdgcn_readfirstlane(ldsbase + (bufoff) + dst0 + i_ * 1024)); } while (0)
#define LOAD_Q(u) do { const bf16_t* qp_ = proj + ((size_t)((u) >> 6) * SEQ + ((u) & 15) * 128 + rg * 32 + r32) * PROJ_W + C_QB + 128 * (((u) >> 4) & 3) + 64 * c + 8 * hi; \
        _Pragma("unroll") for (int s_ = 0; s_ < 4; ++s_) qf[s_] = *(const bf16x8*)(qp_ + 16 * s_); } while (0)
    LAS float* sh_gain = (LAS float*)(lds + 131072 + 2048);
    if (tid < 128) sh_gain[tid] = subln[tid];
    if (u0 >= nunits) return;
    int b0 = 0, b1 = 32768, b2 = 65536;
    bf16x8 qf[4];
    { const char* g0 = UNIT_GSRC(u0); DMA_TILE(g0, 0, b0); DMA_TILE(g0, 1, b1); LOAD_Q(u0); }
    unsigned kL = lane_kL(r32, hi) ^ (128u * c), vL = lane_vL(lane, hi);
    for (int u = u0; u < nunits; u += ustride) {
        const int un = u + ustride; const bool has_next = un < nunits;
        const char* gcur = UNIT_GSRC(u); const char* gnxt = UNIT_GSRC(has_next ? un : u);
        const int qb = u & 15, h = (u >> 4) & 3, b = u >> 6;
        const size_t qrow = (size_t)b * SEQ + qb * 128 + rg * 32 + r32;
        f32x16 o[4];
#pragma unroll
        for (int e = 0; e < 4; ++e)
#pragma unroll
            for (int i = 0; i < 16; ++i) o[e][i] = 0.f;
        float l = 0.f;
        if (u == u0) asm volatile("s_waitcnt vmcnt(0)" ::: "memory");
        __syncthreads();
#define SB_STAGE() __builtin_amdgcn_sched_barrier(0x2 | 0x4 | 0x400)
#define KLOAD(dst, base) do { _Pragma("unroll") for (int ks_ = 0; ks_ < 4; ++ks_) dst[ks_] = *(const LAS bf16x8*)lxor((base), 32u * ks_); } while (0)
#define VLOAD(dst, base, eb0) do { _Pragma("unroll") for (int e_ = 0; e_ < 2; ++e_) { const ldsp_t a0_ = lxor((base), 64u * ((eb0) + e_)), a1_ = lxor((base), (64u * ((eb0) + e_)) ^ 32u); \
            _Pragma("unroll") for (int u_ = 0; u_ < 2; ++u_) { const s16x4 lo_ = vtr(a0_ + 4096 * u_); const s16x4 hh_ = vtr(a1_ + 4096 * u_ + 2048); \
                dst[e_][u_] = (bf16x8){lo_[0], lo_[1], lo_[2], lo_[3], hh_[0], hh_[1], hh_[2], hh_[3]}; } } } while (0)
#define QKMMA(sd, kf) do { _Pragma("unroll") for (int ks_ = 0; ks_ < 4; ++ks_) sd = MFMA32(kf[ks_], qf[ks_], ks_ == 0 ? negv : sd); } while (0)
#define PVMMA(vf, eb0, p0, p1) do { _Pragma("unroll") for (int e_ = 0; e_ < 2; ++e_) { o[(eb0) + e_] = MFMA32(vf[e_][0], p0, o[(eb0) + e_]); o[(eb0) + e_] = MFMA32(vf[e_][1], p1, o[(eb0) + e_]); } } while (0)
        f32x16 negv;
#pragma unroll
        for (int i = 0; i < 16; ++i) negv[i] = negm;
        asm volatile("" : "+v"(negv));
        bf16x8 kfa[4], kfb[4], vfa[2][2], vfb[2][2], pa, pb, pc, pd;
        f32x16 s0, s1;
        KLOAD(kfa, lds + b0 + kL);
        KLOAD(kfb, lds + b0 + 8192 + kL);
        QKMMA(s0, kfa);
        for (int t = 0; t < 32; ++t) {
            asm volatile("" : "+v"(kL), "+v"(vL));
            if (t + 2 < 32) DMA_TILE(gcur, t + 2, b2); else if (has_next) DMA_TILE(gnxt, t - 30, b2);
            ldsp_t vb = lds + b0 + 16384 + vL, kn = lds + b1 + kL;
            VLOAD(vfa, vb, 0);
            QKMMA(s1, kfb);
            exp_pack(s0, l, pa, pb);
            SB_STAGE();
            VLOAD(vfb, vb, 2);
            PVMMA(vfa, 0, pa, pb);
            SB_STAGE();
            KLOAD(kfa, kn);
            PVMMA(vfb, 2, pa, pb);
            exp_pack(s1, l, pc, pd);
            SB_STAGE();
            VLOAD(vfa, vb + 8192, 0);
            QKMMA(s0, kfa);
            SB_STAGE();
            VLOAD(vfb, vb + 8192, 2);
            PVMMA(vfa, 0, pc, pd);
            SB_STAGE();
            KLOAD(kfb, kn + 8192);
            PVMMA(vfb, 2, pc, pd);
            asm volatile("s_waitcnt vmcnt(0)" ::: "memory");
            __syncthreads();
            const int tmp = b0; b0 = b1; b1 = b2; b2 = tmp;
        }
#undef SB_STAGE
#undef KLOAD
#undef VLOAD
#undef QKMMA
#undef PVMMA
        if (has_next) LOAD_Q(un);
        l += __shfl_xor(l, 32);
        LAS float* xch = (LAS float*)(lds + (rg < 2 ? b2 + rg * 16384 : 98304 + (rg - 2) * 16384)) + r32;
        const bf16_t* gp = proj + qrow * PROJ_W + C_GB + 128 * h + 8 * hi;
        if (c == 1) {
            const float i1 = lam / l;
#pragma unroll
            for (int e = 0; e < 4; ++e)
#pragma unroll
                for (int i = 0; i < 16; ++i) xch[(32 * e + crow(i, hi)) * 32] = o[e][i] * i1;
        }
        __syncthreads();
        if (c == 0) {
            u32x4 gc[2], gn2[2];
#pragma unroll
            for (int k = 0; k < 2; ++k) gc[k] = *(const u32x4*)(gp + 16 * k);
            const float i0 = 1.0f / l;
            float ss = 0.f;
#pragma unroll
            for (int e = 0; e < 4; ++e)
#pragma unroll
                for (int i = 0; i < 16; ++i) { const float v = o[e][i] * i0 - xch[(32 * e + crow(i, hi)) * 32]; o[e][i] = v; ss += v * v; }
            ss += __shfl_xor(ss, 32);
            const float rstd = rsqrtf(ss * (1.0f / 128.0f) + RMS_EPS_) * (1.0f - LAMBDA_INIT);
            bf16_t* yp16 = y + qrow * 1024 + 512 + 128 * h + 8 * hi;
#pragma unroll
            for (int e = 0; e < 4; ++e) {
                if (e < 3) {
#pragma unroll
                    for (int k = 0; k < 2; ++k) gn2[k] = *(const u32x4*)(gp + 32 * (e + 1) + 16 * k);
                }
#pragma unroll
                for (int k = 0; k < 2; ++k) {
                    float lo4[4], hi4[4];
#pragma unroll
                    for (int j = 0; j < 4; ++j) {
                        const auto r = __builtin_amdgcn_permlane32_swap(__float_as_uint(o[e][8 * k + j]), __float_as_uint(o[e][8 * k + 4 + j]), false, false);
                        lo4[j] = __uint_as_float(r[0]); hi4[j] = __uint_as_float(r[1]);
                    }
                    const f32x4 ga = *(const LAS f32x4*)(sh_gain + 32 * e + 16 * k + 8 * hi), gb = *(const LAS f32x4*)(sh_gain + 32 * e + 16 * k + 8 * hi + 4);
                    const u32x4 g4v = gc[k];
                    u32x4 w4;
                    w4.x = pk2(lo4[0] * rstd * ga[0] * bf_lo(g4v.x), lo4[1] * rstd * ga[1] * bf_hi(g4v.x)); w4.y = pk2(lo4[2] * rstd * ga[2] * bf_lo(g4v.y), lo4[3] * rstd * ga[3] * bf_hi(g4v.y));
                    w4.z = pk2(hi4[0] * rstd * gb[0] * bf_lo(g4v.z), hi4[1] * rstd * gb[1] * bf_hi(g4v.z)); w4.w = pk2(hi4[2] * rstd * gb[2] * bf_lo(g4v.w), hi4[3] * rstd * gb[3] * bf_hi(g4v.w));
                    *(u32x4*)(yp16 + 32 * e + 16 * k) = w4;
                }
#pragma unroll
                for (int k = 0; k < 2; ++k) gc[k] = gn2[k];
                asm volatile("" ::: "memory");
            }
        }
    }
#undef DMA_TILE
#undef UNIT_GSRC
#undef LOAD_Q
    __syncthreads();
}

__device__ __forceinline__ void attnA_strip(LAS unsigned char* lds, const bf16_t* proj, bf16_t* y, const float* sink, int b, int kvh, int qb0, int nq, float negm) {
    const int tid = threadIdx.x, lane = tid & 63, wid = __builtin_amdgcn_readfirstlane(tid >> 6), r32 = lane & 31, hi = lane >> 5;
    const size_t rowbase = (size_t)b * SEQ;
    const char* gsrc = (const char*)(proj + rowbase * PROJ_W);
    unsigned goff[2];
#pragma unroll
    for (int j = 0; j < 2; ++j) {
        const int blk = 2 * wid + j, row = 4 * blk + (lane >> 4);
        const int ch = (lane & 15) ^ (((lane >> 4) << 2) | (blk & 3));
        const int col = (ch < 8) ? (C_KA + 64 * kvh + 8 * ch) : (C_VA + 64 * kvh + 8 * (ch - 8));
        goff[j] = (unsigned)(row * PROJ_W + col) * 2u;
    }
    const unsigned ldsbase = (unsigned)(uintptr_t)lds;
#define DMA_TILE_A(kt) do { if ((kt) >= 0 && (kt) < 32) { const char* gs_ = gsrc + (size_t)(kt) * (64 * PROJ_W * 2); const unsigned so_ = ((kt) % 6) * 16384 + 2 * wid * 1024; \
        glds16(gs_ + goff[0], (unsigned)__builtin_amdgcn_readfirstlane(ldsbase + so_)); glds16(gs_ + goff[1], (unsigned)__builtin_amdgcn_readfirstlane(ldsbase + so_ + 1024)); } } while (0)
    for (int kt = qb0 - 2; kt <= qb0 + 2; ++kt) DMA_TILE_A(kt);
    const int g = wid & 3, rg = wid >> 2, head = 4 * kvh + g;
    const float sinkv = __builtin_amdgcn_exp2f(sink[head] * LOG2E + negm);
    unsigned kL = lane_kL(r32, hi), vL = lane_vL(lane, hi);
    bf16x8 qf[4];
    {
        const bf16_t* qp = proj + (rowbase + 64 * qb0 + 32 * rg + r32) * PROJ_W + C_QA + 64 * head + 8 * hi;
#pragma unroll
        for (int s = 0; s < 4; ++s) qf[s] = *(const bf16x8*)(qp + 16 * s);
    }
    for (int iq = 0; iq < nq; ++iq) {
        const int qb = qb0 + iq;
        const int qpos = 64 * qb + 32 * rg + r32;
        const size_t qrow = rowbase + qpos;
        f32x16 o[2];
#pragma unroll
        for (int e = 0; e < 2; ++e)
#pragma unroll
            for (int i = 0; i < 16; ++i) o[e][i] = 0.f;
        float l = 0.f;
        if (iq == 0) asm volatile("s_waitcnt vmcnt(0)" ::: "memory"); else asm volatile("s_waitcnt vmcnt(8)" ::: "memory");
        __syncthreads();
        if (iq + 1 < nq) DMA_TILE_A(qb + 3);
        const bf16_t* gp = proj + qrow * PROJ_W + C_GA + 64 * head + 8 * hi;
        u32x4 gt[2][2];
#pragma unroll
        for (int e = 0; e < 2; ++e)
#pragma unroll
            for (int k = 0; k < 2; ++k) gt[e][k] = *(const u32x4*)(gp + 32 * e + 16 * k);
        bf16x8 qn[4];
        {
            const bf16_t* qp = proj + (qrow + ((iq + 1 < nq) ? 64 : 0)) * PROJ_W + C_QA + 64 * head + 8 * hi;
#pragma unroll
            for (int s = 0; s < 4; ++s) qn[s] = *(const bf16x8*)(qp + 16 * s);
        }
        const int qw0 = 64 * qb + 32 * rg;
        const int i_lo = (qw0 - 128 < 0) ? ((128 - qw0) >> 5) : 0;
        const int i_hi = (qw0 + 128 > SEQ - 32) ? ((SEQ - 32 - qw0 + 128) >> 5) : 8;
#define HALF_IMG(i) (lds + (((qw0 - 128 + 32 * (i)) >> 6) % 6) * 16384 + (((qw0 - 128 + 32 * (i)) >> 5) & 1) * 8192)
#define KLOAD_A(dst, base) do { _Pragma("unroll") for (int ks_ = 0; ks_ < 4; ++ks_) dst[ks_] = *(const LAS bf16x8*)lxor((base), 32u * ks_); } while (0)
#define QK_A(sd, kf) do { _Pragma("unroll") for (int ks_ = 0; ks_ < 4; ++ks_) sd = MFMA32(kf[ks_], qf[ks_], ks_ == 0 ? negv : sd); } while (0)
        f32x16 negv;
#pragma unroll
        for (int r = 0; r < 16; ++r) negv[r] = negm;
        asm volatile("" : "+v"(negv));
        bf16x8 kfn[4], vf[2][2];
        f32x16 sc, sn;
#define A_STEP(MASKED) do { \
            const int n1_ = (i + 2 < i_hi) ? i + 2 : i_hi; \
            ldsp_t va_ = HALF_IMG(i) + vL; \
            _Pragma("unroll") for (int eb = 0; eb < 2; ++eb) { const ldsp_t a0 = lxor(va_, 64u * (2 + eb)), a1 = lxor(va_, (64u * (2 + eb)) ^ 32u); \
                _Pragma("unroll") for (int u = 0; u < 2; ++u) { const s16x4 lo = vtr(a0 + 4096 * u); const s16x4 hh = vtr(a1 + 4096 * u + 2048); vf[eb][u] = (bf16x8){lo[0], lo[1], lo[2], lo[3], hh[0], hh[1], hh[2], hh[3]}; } } \
            QK_A(sn, kfn); \
            __builtin_amdgcn_sched_barrier(0x2 | 0x4 | 0x400); \
            KLOAD_A(kfn, HALF_IMG(n1_) + kL); \
            _Pragma("unroll") for (int r = 0; r < 16; ++r) sc[r] = __builtin_amdgcn_exp2f(sc[r]); \
            if (MASKED) { const int dq0 = qpos - (qw0 - 128 + 32 * i); \
                _Pragma("unroll") for (int r = 0; r < 16; ++r) { const int d = dq0 - crow(r, hi); sc[r] = (d <= 128 && d >= -128) ? sc[r] : 0.f; } } \
            float sum = 0.f; \
            _Pragma("unroll") for (int r = 0; r < 16; ++r) sum += sc[r]; \
            l += sum; \
            u32x4 w0, w1; \
            w0.x = cvt_pk_bf16(sc[0], sc[1]); w0.y = cvt_pk_bf16(sc[2], sc[3]); w0.z = cvt_pk_bf16(sc[4], sc[5]); w0.w = cvt_pk_bf16(sc[6], sc[7]); \
            w1.x = cvt_pk_bf16(sc[8], sc[9]); w1.y = cvt_pk_bf16(sc[10], sc[11]); w1.z = cvt_pk_bf16(sc[12], sc[13]); w1.w = cvt_pk_bf16(sc[14], sc[15]); \
            const bf16x8 pk0 = __builtin_bit_cast(bf16x8, w0), pk1 = __builtin_bit_cast(bf16x8, w1); \
            _Pragma("unroll") for (int eb = 0; eb < 2; ++eb) { o[eb] = MFMA32(vf[eb][0], pk0, o[eb]); o[eb] = MFMA32(vf[eb][1], pk1, o[eb]); } \
            sc = sn; } while (0)
        KLOAD_A(kfn, HALF_IMG(i_lo) + kL);
        QK_A(sc, kfn);
        KLOAD_A(kfn, HALF_IMG((i_lo + 1 < i_hi) ? i_lo + 1 : i_hi) + kL);
        int i = i_lo;
        if (i == 0) { A_STEP(true); ++i; }
        const int i_end = (i_hi == 8) ? 7 : i_hi;
#pragma unroll 2
        for (; i <= i_end; ++i) A_STEP(false);
        if (i_hi == 8) A_STEP(true);
#undef A_STEP
#undef KLOAD_A
#undef QK_A
#undef HALF_IMG
        l += __shfl_xor(l, 32);
        l += sinkv;
        const float inv = 1.0f / l;
        bf16_t* yp16 = y + qrow * 1024 + 64 * head + 8 * hi;
#pragma unroll
        for (int e = 0; e < 2; ++e)
#pragma unroll
            for (int k = 0; k < 2; ++k) {
                float lo4[4], hi4[4];
#pragma unroll
                for (int j = 0; j < 4; ++j) {
                    const auto r = __builtin_amdgcn_permlane32_swap(__float_as_uint(o[e][8 * k + j]), __float_as_uint(o[e][8 * k + 4 + j]), false, false);
                    lo4[j] = __uint_as_float(r[0]); hi4[j] = __uint_as_float(r[1]);
                }
                const u32x4 g4v = gt[e][k];
                u32x4 w4;
                w4.x = pk2(lo4[0] * inv * bf_lo(g4v.x), lo4[1] * inv * bf_hi(g4v.x)); w4.y = pk2(lo4[2] * inv * bf_lo(g4v.y), lo4[3] * inv * bf_hi(g4v.y));
                w4.z = pk2(hi4[0] * inv * bf_lo(g4v.z), hi4[1] * inv * bf_hi(g4v.z)); w4.w = pk2(hi4[2] * inv * bf_lo(g4v.w), hi4[3] * inv * bf_hi(g4v.w));
                *(u32x4*)(yp16 + 32 * e + 16 * k) = w4;
            }
#pragma unroll
        for (int s = 0; s < 4; ++s) qf[s] = qn[s];
    }
#undef DMA_TILE_A
    __syncthreads();
}

__device__ __forceinline__ float absmax64(const float* g) { float m = 0.f; for (int i = 0; i < 64; ++i) m = fmaxf(m, fabsf(g[i])); return m; }

__device__ __forceinline__ void phase3(const Ptrs& P, LAS unsigned char* lds) {
    const bf16_t* proj = (const bf16_t*)(P.ws + WS_PROJ);
    bf16_t* y = (bf16_t*)(P.ws + WS_Y);
    const float negmA = -(8.0f * absmax64(P.q_norm_a) * absmax64(P.k_norm_a)) * LOG2E;
    const float negmB = -(8.0f * absmax64(P.q_norm_b) * absmax64(P.k_norm_b)) * LOG2E;
    float d1 = 0.f, d2 = 0.f;
    for (int i = 0; i < 64; ++i) { d1 += P.lq1[i] * P.lk1[i]; d2 += P.lq2[i] * P.lk2[i]; }
    const float lam = expf(d1) - expf(d2) + LAMBDA_INIT;
    const int vblk = ((gridDim.x & 7) == 0) ? (int)((blockIdx.x & 7) * (gridDim.x >> 3) + (blockIdx.x >> 3)) : (int)blockIdx.x;
#ifndef NO_ATTB
    for (int rep = 0; rep < REP3B; ++rep) attnB_stream(lds, proj, y, P.subln, vblk, (int)gridDim.x, BATCH * 4 * 16, negmB, lam);
#endif
    __syncthreads();
#ifndef NO_ATTA
    for (int rep = 0; rep < REP3A; ++rep)
    for (int st = vblk; st < BATCH * 2 * 4; st += gridDim.x) {
        const int q8 = st & 3, kvh = (st >> 2) & 1, b = st >> 3;
        attnA_strip(lds, proj, y, P.sink_a, b, kvh, 8 * q8, 8, negmA);
    }
#endif
}

#define XB_TMO      128
#define XB_XCNT(j)  (256  + 64 * (j))
#define XB_XSUB(j)  (1280 + 64 * (j))
#define XB_XGEN(j)  (2304 + 64 * (j))
#define XB_TOP      3328
#define XB_TOPGEN   3392
#define XCD_BAR_WORDS 3456
#define XB_SPIN_CAP (1u << 18)

__device__ __forceinline__ unsigned xb_ld(unsigned* p)              { return __hip_atomic_load(p, __ATOMIC_RELAXED, __HIP_MEMORY_SCOPE_AGENT); }
__device__ __forceinline__ unsigned xb_add(unsigned* p, unsigned v) { return __hip_atomic_fetch_add(p, v, __ATOMIC_RELAXED, __HIP_MEMORY_SCOPE_AGENT); }
__device__ __forceinline__ unsigned xb_xcc_id() { return (unsigned)__builtin_amdgcn_s_getreg((3 << 11) | 20) & 0xFu; }
#define XB_SPIN(cond, bar) do { unsigned _sp = 0; while (cond) { __builtin_amdgcn_s_sleep(1); \
    if ((++_sp & 255u) == 0u) { if (xb_ld(&(bar)[XB_TMO])) break; if (_sp > XB_SPIN_CAP) { atomicAdd(&(bar)[XB_TMO], 1u); break; } } } } while (0)

struct XcdBarrier {
    unsigned* bar; unsigned x;
    volatile LAS unsigned* st;
};

__device__ __forceinline__ XcdBarrier xcd_barrier_post(unsigned* bar, volatile LAS unsigned* st) {
    XcdBarrier b; b.bar = bar; b.x = xb_xcc_id(); b.st = st;
    if (threadIdx.x == 0) (void)xb_add(&bar[XB_XCNT(b.x)], 1u);
    return b;
}
__device__ __forceinline__ void xcd_barrier_complete(unsigned* bar, unsigned x, unsigned& nloc, unsigned& nx) {
    const unsigned G = gridDim.x * gridDim.y * gridDim.z;
    unsigned sum, cnt, mine, sp = 0u;
    for (;;) {
        sum = 0u; cnt = 0u; mine = 0u;
#pragma unroll
        for (unsigned j = 0; j < 16; ++j) { const unsigned c = xb_ld(&bar[XB_XCNT(j)]); sum += c; cnt += (c > 0u) ? 1u : 0u; mine = (j == x) ? c : mine; }
        if (sum == G) break;
        __builtin_amdgcn_s_sleep(1);
        if ((++sp & 255u) == 0u) { if (xb_ld(&bar[XB_TMO])) break; if (sp > XB_SPIN_CAP) { atomicAdd(&bar[XB_TMO], 1u); break; } }
    }
    nloc = mine > 0u ? mine : 1u; nx = cnt > 0u ? cnt : 1u;
}

__device__ __forceinline__ void xcd_barrier(const XcdBarrier& b) {
    asm volatile("s_waitcnt vmcnt(0)" ::: "memory");
    __syncthreads();
    if (threadIdx.x == 0) {
        unsigned* bar = b.bar;
        __builtin_amdgcn_s_waitcnt(0);
        unsigned nloc = b.st[0], nx = b.st[1];
        if (nloc == 0u) { xcd_barrier_complete(bar, b.x, nloc, nx); b.st[0] = nloc; b.st[1] = nx; }
        const unsigned old = xb_add(&bar[XB_XSUB(b.x)], 1u);
        const unsigned gen = old / nloc;
        if (old + 1u == (gen + 1u) * nloc) {
            __builtin_amdgcn_fence(__ATOMIC_RELEASE, "agent");
            asm volatile("s_waitcnt vmcnt(0)" ::: "memory");
            const unsigned og = xb_add(&bar[XB_TOP], 1u);
            const unsigned tg = og / nx;
            if (og + 1u == (tg + 1u) * nx) xb_add(&bar[XB_TOPGEN], 1u);
            else XB_SPIN(xb_ld(&bar[XB_TOPGEN]) == tg, bar);
            __builtin_amdgcn_fence(__ATOMIC_ACQUIRE, "agent");
            xb_add(&bar[XB_XGEN(b.x)], 1u);
            asm volatile("s_waitcnt vmcnt(0)" ::: "memory");
        } else {
            XB_SPIN(xb_ld(&bar[XB_XGEN(b.x)]) == gen, bar);
            __builtin_amdgcn_fence(__ATOMIC_ACQUIRE, "agent");
            asm volatile("s_waitcnt vmcnt(0)" ::: "memory");
        }
    }
    __syncthreads();
}

__global__ void __launch_bounds__(NTHREADS) hymba_fwd(Ptrs P) {
    extern __shared__ __attribute__((aligned(1024))) unsigned char lds_raw[];
    LAS unsigned char* lds = (LAS unsigned char*)lds_raw;
    cg::grid_group grid = cg::this_grid();
    const int lane = threadIdx.x & 63, wave = __builtin_amdgcn_readfirstlane(threadIdx.x >> 6);
    const int lo = P.ph_lo, hi = P.ph_hi;
    if (lo < 0) grid.sync();
    volatile LAS unsigned* bar_st = (volatile LAS unsigned*)(lds + 131072 + 1024);
    if (threadIdx.x < 2) bar_st[threadIdx.x] = 0u;
    __syncthreads();
    XcdBarrier bar = xcd_barrier_post((unsigned*)(P.ws + WS_CTL), bar_st);
#ifndef PHMASK
#define PHMASK 31
#endif
#define IN(k) (((PHMASK >> (k)) & 1) && lo <= (k) && (k) < hi)
#define SEAM(k) do { if (IN(k) && IN((k) + 1)) xcd_barrier(bar); } while (0)
    if (IN(0)) for (int rep = 0; rep < REP0; ++rep) phase0(P, lds, wave, lane);
    SEAM(0);
    if (IN(1)) for (int rep = 0; rep < REP1; ++rep) phase1(P, lds, wave, lane);
    SEAM(1);
    if (IN(2)) {
        __syncthreads();
        pg8::Gemm g{(const bf16_t*)(P.ws + WS_H), (const bf16_t*)(P.ws + WS_WIN), MROWS, 3328, 1024};
        pg8::StaticOrder S; S.init(MROWS, 3328, gridDim.x, (int)blockIdx.x, WGM_G1);
        pg8::EpiProj E{(bf16_t*)(P.ws + WS_PROJ), (const float*)(P.ws + WS_ROPE), P.q_norm_a, P.k_norm_a, P.q_norm_b, P.k_norm_b};
        pg8::gemm_phase<pg8::EpiProj, pg8::StaticOrder, true, true>(lds, g, S, E);
#if REP2 == 2
        __syncthreads();
        pg8::gemm_phase<pg8::EpiProj, pg8::StaticOrder, true, true>(lds, g, S, E);
#endif
    }
    SEAM(2);
    if (IN(3)) { __syncthreads(); phase3(P, lds); }
    SEAM(3);
    if (IN(4)) {
        __syncthreads();
        pg8::Gemm g{(const bf16_t*)(P.ws + WS_Y), (const bf16_t*)(P.ws + WS_WOUT), MROWS, 1024, 1024};
        pg8::StaticOrder S; S.init(MROWS, 1024, gridDim.x, (int)blockIdx.x, WGM_G2);
        pg8::EpiOut E{P.x, P.out, (const float*)(P.ws + WS_MOD) + 2048};
        pg8::gemm_phase<pg8::EpiOut, pg8::StaticOrder, true, true>(lds, g, S, E);
#if REP4 == 2
        __syncthreads();
        pg8::gemm_phase<pg8::EpiOut, pg8::StaticOrder, true, true>(lds, g, S, E);
#endif
    }
#undef IN
#undef SEAM
}

#ifndef MK_N_LAUNCHES
#define MK_N_LAUNCHES 1
#endif

extern "C" void kernel_launch(void* const* d_in, const int* in_sizes, int n_in, void* d_out, int out_size, void* d_ws, size_t ws_size, hipStream_t stream) {
    static int grid = 0;
    if (grid == 0) {
        if (n_in != 18 || ws_size < WS_END) { fprintf(stderr, "kernel_launch: unexpected n_in %d / ws_size %zu\n", n_in, ws_size); grid = -1; return; }
        int dev = 0, cus = 0, per_cu = 0;
        hipGetDevice(&dev);
        hipDeviceGetAttribute(&cus, hipDeviceAttributeMultiprocessorCount, dev);
        if (hipFuncSetAttribute((const void*)hymba_fwd, hipFuncAttributeMaxDynamicSharedMemorySize, LDS_BYTES) != hipSuccess) { fprintf(stderr, "kernel_launch: hipFuncSetAttribute failed\n"); grid = -1; return; }
        if (hipOccupancyMaxActiveBlocksPerMultiprocessor(&per_cu, (const void*)hymba_fwd, NTHREADS, LDS_BYTES) != hipSuccess || per_cu < 1) { fprintf(stderr, "kernel_launch: occupancy query says %d blocks/CU\n", per_cu); (void)hipGetLastError(); grid = -1; return; }
        grid = cus * per_cu;
        if (grid > 256) grid = 256;
    }
    if (grid < 0) return;
    if (hipMemsetAsync((char*)d_ws + WS_CTL, 0, CTL_BYTES, stream) != hipSuccess) { fprintf(stderr, "kernel_launch: memset of the barrier words failed\n"); return; }
    Ptrs p{};
    p.x = (const float*)d_in[0]; p.c = (const float*)d_in[1]; p.positions = (const int*)d_in[2]; p.w_ada = (const float*)d_in[3]; p.b_ada = (const float*)d_in[4];
    p.norm_gain = (const float*)d_in[5]; p.w_in = (const float*)d_in[6]; p.q_norm_a = (const float*)d_in[7]; p.k_norm_a = (const float*)d_in[8]; p.sink_a = (const float*)d_in[9];
    p.q_norm_b = (const float*)d_in[10]; p.k_norm_b = (const float*)d_in[11]; p.lq1 = (const float*)d_in[12]; p.lk1 = (const float*)d_in[13]; p.lq2 = (const float*)d_in[14];
    p.lk2 = (const float*)d_in[15]; p.subln = (const float*)d_in[16]; p.w_out = (const float*)d_in[17];
    p.out = (float*)d_out; p.ws = (unsigned char*)d_ws;
#if MK_N_LAUNCHES == 1
    p.ph_lo = 0; p.ph_hi = 5;
    void* args[] = {&p};
    hipError_t e = hipLaunchCooperativeKernel((const void*)hymba_fwd, dim3(grid), dim3(NTHREADS), args, LDS_BYTES, stream);
    if (e != hipSuccess) fprintf(stderr, "cooperative launch failed: %s (grid %d)\n", hipGetErrorString(e), grid);
#else
    for (int k = 0; k < 5; ++k) { p.ph_lo = k; p.ph_hi = k + 1; hipLaunchKernelGGL(hymba_fwd, dim3(grid), dim3(NTHREADS), LDS_BYTES, stream, p); }
#endif
}
```

```cpp
#include <hip/hip_runtime.h>
#include <hip/hip_cooperative_groups.h>
#include <cstdio>
#include <cstdint>
namespace cg = cooperative_groups;
#ifndef WGM_G1
#define WGM_G1 4
#endif
#ifndef WGM_G2
#define WGM_G2 4
#endif
#ifndef REP0
#define REP0 1
#endif
#ifndef REP1
#define REP1 1
#endif
#ifndef REP2
#define REP2 1
#endif
#ifndef REP3A
#define REP3A 1
#endif
#ifndef REP3B
#define REP3B 1
#endif
#ifndef REP4
#define REP4 1
#endif

namespace pg8 {
#define PG8_LAS __attribute__((address_space(3)))
typedef unsigned short bf16_t;
typedef short bf16x8 __attribute__((ext_vector_type(8)));
typedef float f32x4 __attribute__((ext_vector_type(4)));
typedef unsigned u32x4 __attribute__((ext_vector_type(4)));
constexpr int BM = 256, BK = 64, HALF = 128, HTB = HALF * BK * 2  , STAGE_BYTES = 8 * HTB, NXCD = 8;

__host__ __device__ __forceinline__ int lds_byte(int r, int c) { const int st = (r >> 4) * 2 + (c >> 5), rr = r & 15, cc = c & 31, ob = rr * 64 + cc * 2; return st * 1024 + (ob ^ (((ob >> 9) & 1) << 5)); }
__host__ __device__ __forceinline__ void stage_rc(int b, int& R, int& C) { const int st = b / 1024, sb = b % 1024, swz = sb ^ (((sb >> 9) & 1) << 5); R = (st >> 1) * 16 + swz / 64; C = (st & 1) * 32 + (swz % 64) / 2; }
__host__ __device__ __forceinline__ int perm32(int rho) { const int n = rho >> 4, i = rho & 15; return 8 * (i >> 2) + 4 * n + (i & 3); }

struct Unit { int pm, pn; };
struct Gemm { const bf16_t* A; const bf16_t* Bt; int M, N, K; };

struct StaticOrder {
    int nM, nN, nwg, G, c, WGM;
    __host__ __device__ void init(int M, int N, int G_, int c_, int wgm_ = 8) { nM = M / BM; nN = N / BM; nwg = nM * nN; G = G_; c = c_; WGM = wgm_; }
    __host__ __device__ bool next(int i, Unit& u) const {
        const long L = (long)i * G + c; if (L >= nwg) return false;
        int wgid = (int)L; { const int q = nwg / NXCD, r = nwg % NXCD, xcd = wgid % NXCD, off = wgid / NXCD; wgid = (xcd < r ? xcd * (q + 1) : r * (q + 1) + (xcd - r) * q) + off; }
        const int nig = WGM * nN, gid = wgid / nig, fm = gid * WGM, gsz = (nM - fm) < WGM ? (nM - fm) : WGM;
        u.pm = fm + ((wgid % nig) % gsz); u.pn = (wgid % nig) / gsz; return true;
    }
    __device__ __forceinline__ void a_ready(const Unit&) const {}
    __device__ __forceinline__ void done(const Unit&) const {}
};

typedef float f32x2 __attribute__((ext_vector_type(2)));
typedef __bf16 bf16x2_t __attribute__((ext_vector_type(2)));
__device__ __forceinline__ unsigned cvt_pk_bf16(float lo, float hi) { f32x2 v = {lo, hi}; bf16x2_t b = __builtin_convertvector(v, bf16x2_t); return __builtin_bit_cast(unsigned, b); }

constexpr int PROJ_W = 3328;
constexpr float QSCALE = 0.125f * 1.4426950408889634f;
constexpr float RMS_EPS = 1e-6f;

struct EpiProj {
    static constexpr bool PERM = true, AFTER_DRAIN = false;
    bf16_t* O; const float* rope; const float *gqa, *gka, *gqb, *gkb;
    __device__ __forceinline__ void operator()(const f32x4 (&acc)[2][2][4][2], const Unit& u, int wr, int wc, int fr, int fq) const {
        const int colh = u.pn * 256 + wc * 64;
        int mode; const float* gain = gqa; float osc = 1.f;
        if (colh < 512) { mode = 1; gain = gqa; osc = QSCALE; }
        else if (colh < 640) { mode = 1; gain = gka; }
        else if (colh < 768) mode = 0;
        else if (colh < 1280) mode = 2;
        else if (colh < 1792) { mode = 1; gain = gqb; osc = QSCALE; }
        else if (colh < 2304) { mode = 1; gain = gkb; }
        else if (colh < 2816) mode = 0;
        else mode = 2;
        const int row0 = u.pm * BM + wr * 64 + fr;
        if (mode == 1) {
            f32x4 g[2][2];
#pragma unroll
            for (int bj = 0; bj < 2; ++bj)
#pragma unroll
                for (int n = 0; n < 2; ++n) g[bj][n] = *(const f32x4*)(gain + 32 * bj + 8 * fq + 4 * n) * osc;
            f32x4 rc[4], rn[4];
#define ROPE_LOAD(dst, g_) do { const float* rp_ = rope + (size_t)(row0 + ((g_) >> 2) * HALF + ((g_) & 3) * 16) * 64 + 8 * fq; \
                dst[0] = *(const f32x4*)(rp_); dst[1] = *(const f32x4*)(rp_ + 4); dst[2] = *(const f32x4*)(rp_ + 32); dst[3] = *(const f32x4*)(rp_ + 36); } while (0)
            ROPE_LOAD(rc, 0);
#pragma unroll
            for (int gi = 0; gi < 8; ++gi) {
                const int ai = gi >> 2, m = gi & 3;
                if (gi < 7) ROPE_LOAD(rn, gi + 1);
                const int row = row0 + ai * HALF + m * 16;
                const f32x4 c0 = rc[0], c1 = rc[1], s0 = rc[2], s1 = rc[3];
                float ss = 0.f;
#pragma unroll
                for (int bj = 0; bj < 2; ++bj)
#pragma unroll
                    for (int n = 0; n < 2; ++n) { const f32x4 v = acc[ai][bj][m][n]; ss += (v[0] * v[0] + v[1] * v[1]) + (v[2] * v[2] + v[3] * v[3]); }
                ss += __shfl_xor(ss, 16); ss += __shfl_xor(ss, 32);
                const float rstd = rsqrtf(ss * (1.0f / 64.0f) + RMS_EPS);
                const f32x4 a0 = acc[ai][0][m][0] * rstd * g[0][0], a1 = acc[ai][0][m][1] * rstd * g[0][1];
                const f32x4 b0 = acc[ai][1][m][0] * rstd * g[1][0], b1 = acc[ai][1][m][1] * rstd * g[1][1];
                const f32x4 o00 = a0 * c0 - b0 * s0, o01 = a1 * c1 - b1 * s1, o10 = b0 * c0 + a0 * s0, o11 = b1 * c1 + a1 * s1;
                bf16_t* op = O + (size_t)row * PROJ_W + colh + 8 * fq;
                u32x4 w; w.x = cvt_pk_bf16(o00[0], o00[1]); w.y = cvt_pk_bf16(o00[2], o00[3]); w.z = cvt_pk_bf16(o01[0], o01[1]); w.w = cvt_pk_bf16(o01[2], o01[3]);
                *(u32x4*)op = w;
                w.x = cvt_pk_bf16(o10[0], o10[1]); w.y = cvt_pk_bf16(o10[2], o10[3]); w.z = cvt_pk_bf16(o11[0], o11[1]); w.w = cvt_pk_bf16(o11[2], o11[3]);
                *(u32x4*)(op + 32) = w;
#pragma unroll
                for (int k = 0; k < 4; ++k) rc[k] = rn[k];
            }
#undef ROPE_LOAD
        } else if (mode == 2) {
#pragma unroll
            for (int ai = 0; ai < 2; ++ai)
#pragma unroll
                for (int m = 0; m < 4; ++m) {
                    const int row = row0 + ai * HALF + m * 16;
                    bf16_t* op = O + (size_t)row * PROJ_W + colh + 8 * fq;
#pragma unroll
                    for (int bj = 0; bj < 2; ++bj) {
                        f32x4 v0 = acc[ai][bj][m][0], v1 = acc[ai][bj][m][1];
#pragma unroll
                        for (int j = 0; j < 4; ++j) { v0[j] = v0[j] * __builtin_amdgcn_rcpf(1.0f + __builtin_amdgcn_exp2f(-1.4426950408889634f * v0[j])); v1[j] = v1[j] * __builtin_amdgcn_rcpf(1.0f + __builtin_amdgcn_exp2f(-1.4426950408889634f * v1[j])); }
                        u32x4 w; w.x = cvt_pk_bf16(v0[0], v0[1]); w.y = cvt_pk_bf16(v0[2], v0[3]); w.z = cvt_pk_bf16(v1[0], v1[1]); w.w = cvt_pk_bf16(v1[2], v1[3]);
                        *(u32x4*)(op + 32 * bj) = w;
                    }
                }
        } else {
#pragma unroll
            for (int ai = 0; ai < 2; ++ai)
#pragma unroll
                for (int m = 0; m < 4; ++m) {
                    const int row = row0 + ai * HALF + m * 16;
                    bf16_t* op = O + (size_t)row * PROJ_W + colh + 8 * fq;
#pragma unroll
                    for (int bj = 0; bj < 2; ++bj) {
                        const f32x4 v0 = acc[ai][bj][m][0], v1 = acc[ai][bj][m][1];
                        u32x4 w; w.x = cvt_pk_bf16(v0[0], v0[1]); w.y = cvt_pk_bf16(v0[2], v0[3]); w.z = cvt_pk_bf16(v1[0], v1[1]); w.w = cvt_pk_bf16(v1[2], v1[3]);
                        *(u32x4*)(op + 32 * bj) = w;
                    }
                }
        }
    }
};

struct EpiOut {
    static constexpr bool PERM = true, AFTER_DRAIN = false;
    const float* __restrict__ x; float* __restrict__ out; const float* __restrict__ gate;
    __device__ __forceinline__ void operator()(const f32x4 (&acc)[2][2][4][2], const Unit& u, int wr, int wc, int fr, int fq) const {
        const int row0 = u.pm * BM + wr * 64 + fr, col0 = u.pn * BM + wc * 32 + 8 * fq;
        const float* gp = gate + (size_t)(u.pm >> 3) * 3072 + col0;
        f32x4 gv[2][2];
#pragma unroll
        for (int bj = 0; bj < 2; ++bj)
#pragma unroll
            for (int n = 0; n < 2; ++n) gv[bj][n] = *(const f32x4*)(gp + bj * HALF + 4 * n);
        f32x4 xc[2][2][2], xn[2][2][2];
#define EPI_LOAD(dst, b) do { _Pragma("unroll") for (int mm = 0; mm < 2; ++mm) { const size_t off_ = (size_t)(row0 + ((b) >> 1) * HALF + (2 * ((b) & 1) + mm) * 16) * 1024 + col0; \
            _Pragma("unroll") for (int bj = 0; bj < 2; ++bj) _Pragma("unroll") for (int n = 0; n < 2; ++n) dst[mm][bj][n] = __builtin_nontemporal_load((const f32x4*)(x + off_ + bj * HALF + 4 * n)); } } while (0)
        EPI_LOAD(xc, 0);
#pragma unroll
        for (int b = 0; b < 4; ++b) {
            if (b < 3) EPI_LOAD(xn, b + 1);
#pragma unroll
            for (int mm = 0; mm < 2; ++mm) {
                const size_t off = (size_t)(row0 + (b >> 1) * HALF + (2 * (b & 1) + mm) * 16) * 1024 + col0;
#pragma unroll
                for (int bj = 0; bj < 2; ++bj)
#pragma unroll
                    for (int n = 0; n < 2; ++n) *(f32x4*)(out + off + bj * HALF + 4 * n) = xc[mm][bj][n] + gv[bj][n] * acc[b >> 1][bj][2 * (b & 1) + mm][n];
            }
#pragma unroll
            for (int mm = 0; mm < 2; ++mm)
#pragma unroll
                for (int bj = 0; bj < 2; ++bj)
#pragma unroll
                    for (int n = 0; n < 2; ++n) xc[mm][bj][n] = xn[mm][bj][n];
        }
#undef EPI_LOAD
    }
};

template <class Epi, class Sched, bool ALIGN_EPI = false, bool SP2 = false>
__device__ __forceinline__ void gemm_phase(PG8_LAS unsigned char* lds, const Gemm g, const Sched& S, const Epi& E) {
    const int tid = threadIdx.x, wid = __builtin_amdgcn_readfirstlane(tid >> 6), lane = tid & 63, wr = wid >> 2, wc = wid & 3, fr = lane & 15, fq = lane >> 4;
    const int K = g.K, nt = K / BK;
    unsigned voffA[2], voffB[2];
#pragma unroll
    for (int i = 0; i < 2; ++i) { int R, C; stage_rc(tid * 16 + i * 8192, R, C); const int Rb = Epi::PERM ? ((R & ~31) + perm32(R & 31)) : R;
        voffA[i] = (unsigned)(R * K + C) * 2u; voffB[i] = (unsigned)(Rb * K + C) * 2u; }
    const size_t kstep = (size_t)(BK * 2);
    const size_t hstep = (size_t)HALF * K * 2;
    const size_t tstep = 2 * hstep;
    const unsigned ldsw = (unsigned)wid * 1024u;
    const int aoff = lds_byte(wr * 64 + fr, fq * 8), boff = lds_byte(wc * 32 + fr, fq * 8);
#define PG8_SA(b, h) (((b) * 2 + (h)) * HTB)
#define PG8_SB(b, h) ((4 + (b) * 2 + (h)) * HTB)
#define PG8_STAGE(bufoff, gbase, voff) do { _Pragma("unroll") for (int _i = 0; _i < 2; ++_i) \
        __builtin_amdgcn_global_load_lds((const unsigned*)((const char*)(gbase) + (voff)[_i]), (PG8_LAS unsigned*)(lds + (bufoff) + ldsw + _i * 8192), 16, 0, 0); } while (0)
#define PG8_LDA(dst, b, h) do { _Pragma("unroll") for (int m = 0; m < 4; ++m) _Pragma("unroll") for (int k = 0; k < 2; ++k) dst[m][k] = *(const PG8_LAS bf16x8*)(lds + PG8_SA(b, h) + aoff + m * 2048 + k * 1024); } while (0)
#define PG8_LDB(dst, b, h) do { _Pragma("unroll") for (int n = 0; n < 2; ++n) _Pragma("unroll") for (int k = 0; k < 2; ++k) dst[n][k] = *(const PG8_LAS bf16x8*)(lds + PG8_SB(b, h) + boff + n * 2048 + k * 1024); } while (0)
#define PG8_MMA(ai, bj, At, Bt) do { __builtin_amdgcn_s_setprio(1); _Pragma("unroll") for (int m = 0; m < 4; ++m) _Pragma("unroll") for (int n = 0; n < 2; ++n) _Pragma("unroll") for (int k = 0; k < 2; ++k) \
        acc[ai][bj][m][n] = __builtin_amdgcn_mfma_f32_16x16x32_bf16(Bt[n][k], At[m][k], acc[ai][bj][m][n], 0, 0, 0); __builtin_amdgcn_s_setprio(0); } while (0)
#define PG8_WAIT_V(n) asm volatile("s_waitcnt vmcnt(" #n ")" ::: "memory")
#define PG8_WAIT_L(n) asm volatile("s_waitcnt lgkmcnt(" #n ")" ::: "memory")
#define PG8_BAR __builtin_amdgcn_s_barrier()
#define PG8_SCHED __builtin_amdgcn_sched_barrier(0)
    Unit cur, nxt; int ui = 0;
    if (!S.next(0, cur)) return;
    f32x4 acc[2][2][4][2];
#pragma unroll
    for (int a = 0; a < 2; ++a)
#pragma unroll
        for (int b = 0; b < 2; ++b)
#pragma unroll
            for (int m = 0; m < 4; ++m)
#pragma unroll
                for (int n = 0; n < 2; ++n) acc[a][b][m][n] = (f32x4){0.f, 0.f, 0.f, 0.f};
    bf16x8 At[4][2], B0[2][2], B1[2][2];
    const char* cA = (const char*)g.A + (size_t)cur.pm * tstep; const char* cB = (const char*)g.Bt + (size_t)cur.pn * tstep;
    S.a_ready(cur);
    if constexpr (SP2) {
        PG8_STAGE(PG8_SB(0, 0), cB, voffB); PG8_STAGE(PG8_SB(0, 1), cB + hstep, voffB); PG8_STAGE(PG8_SA(0, 0), cA, voffA); PG8_STAGE(PG8_SA(0, 1), cA + hstep, voffA);
        if (wr == 1) PG8_BAR;
        PG8_WAIT_V(2); PG8_BAR;
        PG8_STAGE(PG8_SB(1, 0), cB + kstep, voffB); PG8_STAGE(PG8_SA(1, 0), cA + kstep, voffA); PG8_STAGE(PG8_SB(1, 1), cB + hstep + kstep, voffB);
        PG8_WAIT_V(6); PG8_BAR;
    } else {
        PG8_STAGE(PG8_SB(0, 0), cB, voffB); PG8_STAGE(PG8_SA(0, 0), cA, voffA); PG8_STAGE(PG8_SB(0, 1), cB + hstep, voffB); PG8_STAGE(PG8_SA(0, 1), cA + hstep, voffA);
        if (wr == 1) PG8_BAR;
        PG8_WAIT_V(4); PG8_BAR;
        PG8_STAGE(PG8_SB(1, 0), cB + kstep, voffB); PG8_STAGE(PG8_SA(1, 0), cA + kstep, voffA); PG8_STAGE(PG8_SB(1, 1), cB + hstep + kstep, voffB);
        PG8_WAIT_V(6); PG8_BAR;
    }
    for (;;) {
        const bool has_next = S.next(ui + 1, nxt);
        const char* nA = has_next ? (const char*)g.A + (size_t)nxt.pm * tstep : cA; const char* nB = has_next ? (const char*)g.Bt + (size_t)nxt.pn * tstep : cB;
        for (int t = 0; t < nt; t += 2) {
            const bool last = (t == nt - 2);
            const char* a1 = cA + (size_t)(t + 1) * kstep;
            const char* a2 = last ? nA : cA + (size_t)(t + 2) * kstep; const char* b2 = last ? nB : cB + (size_t)(t + 2) * kstep;
            const char* a3 = a2 + kstep; const char* b3 = b2 + kstep;
            if (last && has_next) S.a_ready(nxt);
            if constexpr (SP2) {
            PG8_LDB(B0, 0, 0); PG8_LDB(B1, 0, 1); PG8_SCHED; PG8_LDA(At, 0, 0); PG8_STAGE(PG8_SA(1, 1), a1 + hstep, voffA);
            PG8_WAIT_V(8); PG8_WAIT_L(0); PG8_BAR; PG8_MMA(0, 0, At, B0); PG8_MMA(0, 1, At, B1); PG8_BAR; PG8_SCHED;
            PG8_LDA(At, 0, 1); PG8_STAGE(PG8_SB(0, 0), b2, voffB); PG8_STAGE(PG8_SB(0, 1), b2 + hstep, voffB); PG8_STAGE(PG8_SA(0, 0), a2, voffA);
            PG8_WAIT_V(8); PG8_WAIT_L(0); PG8_BAR; PG8_MMA(1, 0, At, B0); PG8_MMA(1, 1, At, B1); PG8_BAR; PG8_SCHED;
            PG8_LDB(B0, 1, 0); PG8_LDB(B1, 1, 1); PG8_SCHED; PG8_LDA(At, 1, 0); PG8_STAGE(PG8_SA(0, 1), a2 + hstep, voffA);
            PG8_WAIT_V(8); PG8_WAIT_L(0); PG8_BAR; PG8_MMA(0, 0, At, B0); PG8_MMA(0, 1, At, B1); PG8_BAR; PG8_SCHED;
            PG8_LDA(At, 1, 1); PG8_STAGE(PG8_SB(1, 0), b3, voffB); PG8_STAGE(PG8_SB(1, 1), b3 + hstep, voffB); PG8_STAGE(PG8_SA(1, 0), a3, voffA);
            PG8_WAIT_V(8); PG8_WAIT_L(0); PG8_BAR; PG8_MMA(1, 0, At, B0); PG8_MMA(1, 1, At, B1); PG8_BAR; PG8_SCHED;
            } else {
            PG8_LDB(B0, 0, 0); PG8_SCHED; PG8_LDA(At, 0, 0); PG8_STAGE(PG8_SA(1, 1), a1 + hstep, voffA);
            PG8_WAIT_L(8); PG8_BAR; PG8_WAIT_L(0); PG8_MMA(0, 0, At, B0); PG8_BAR; PG8_SCHED;
            PG8_LDB(B1, 0, 1); PG8_STAGE(PG8_SB(0, 0), b2, voffB);
            PG8_BAR; PG8_WAIT_L(0); PG8_MMA(0, 1, At, B1); PG8_BAR;
            PG8_LDA(At, 0, 1); PG8_STAGE(PG8_SA(0, 0), a2, voffA);
            PG8_BAR; PG8_WAIT_L(0); PG8_MMA(1, 0, At, B0); PG8_BAR; PG8_SCHED;
            PG8_STAGE(PG8_SB(0, 1), b2 + hstep, voffB);
            PG8_WAIT_V(6); PG8_BAR; PG8_MMA(1, 1, At, B1); PG8_BAR;
            PG8_LDB(B0, 1, 0); PG8_SCHED; PG8_LDA(At, 1, 0); PG8_STAGE(PG8_SA(0, 1), a2 + hstep, voffA);
            PG8_WAIT_L(8); PG8_BAR; PG8_WAIT_L(0); PG8_MMA(0, 0, At, B0); PG8_BAR; PG8_SCHED;
            PG8_LDB(B1, 1, 1); PG8_STAGE(PG8_SB(1, 0), b3, voffB);
            PG8_BAR; PG8_WAIT_L(0); PG8_MMA(0, 1, At, B1); PG8_BAR;
            PG8_LDA(At, 1, 1); PG8_STAGE(PG8_SA(1, 0), a3, voffA);
            PG8_BAR; PG8_WAIT_L(0); PG8_MMA(1, 0, At, B0); PG8_BAR; PG8_SCHED;
            PG8_STAGE(PG8_SB(1, 1), b3 + hstep, voffB);
            PG8_WAIT_V(6); PG8_BAR; PG8_MMA(1, 1, At, B1); PG8_BAR;
            }
        }
        if constexpr (ALIGN_EPI) { if (wr == 0) PG8_BAR; }
        if constexpr (!Epi::AFTER_DRAIN) { E(acc, cur, wr, wc, fr, fq); S.done(cur); }
        if (!has_next) break;
#pragma unroll
        for (int a = 0; a < 2; ++a)
#pragma unroll
            for (int b = 0; b < 2; ++b)
#pragma unroll
                for (int m = 0; m < 4; ++m)
#pragma unroll
                    for (int n = 0; n < 2; ++n) acc[a][b][m][n] = (f32x4){0.f, 0.f, 0.f, 0.f};
        cur = nxt; cA = nA; cB = nB; ++ui;
        if constexpr (ALIGN_EPI) { if (wr == 1) PG8_BAR; }
    }
    PG8_WAIT_V(0);
    if constexpr (!ALIGN_EPI) { if (wr == 0) PG8_BAR; }
    PG8_BAR;
    if constexpr (Epi::AFTER_DRAIN) { E.fused(acc, cur, wr, wc, fr, fq, lds, wid, lane); S.done(cur); }
#undef PG8_SA
#undef PG8_SB
#undef PG8_STAGE
#undef PG8_LDA
#undef PG8_LDB
#undef PG8_MMA
#undef PG8_WAIT_V
#undef PG8_WAIT_L
#undef PG8_BAR
#undef PG8_SCHED
}
}

constexpr int D_MODEL = 1024, BATCH = 32, SEQ = 2048, MROWS = BATCH * SEQ;
constexpr int NWAVES = 8, NTHREADS = 512;
constexpr float LOG2E = 1.4426950408889634f;
constexpr float RMS_EPS_ = 1e-6f;
constexpr float LAMBDA_INIT = 0.2f;
constexpr int C_QA = 0, C_KA = 512, C_VA = 640, C_GA = 768, C_QB = 1280, C_KB = 1792, C_VB = 2304, C_GB = 2816;

#define LAS __attribute__((address_space(3)))
typedef unsigned short bf16_t;
typedef short bf16x8 __attribute__((ext_vector_type(8)));
typedef short s16x4 __attribute__((ext_vector_type(4)));
typedef float f32x4 __attribute__((ext_vector_type(4)));
typedef float f32x16 __attribute__((ext_vector_type(16)));
typedef unsigned u32x4 __attribute__((ext_vector_type(4)));
typedef unsigned u32x2 __attribute__((ext_vector_type(2)));
using pg8::cvt_pk_bf16; using pg8::PROJ_W;

constexpr size_t MiB = 1u << 20;
constexpr size_t WS_MODP = 0;
constexpr size_t WS_CTL = 12 * MiB, CTL_BYTES = 16384;
constexpr size_t WS_MOD = 8 * MiB;
constexpr size_t WS_WIN = 16 * MiB;
constexpr size_t WS_WOUT = 24 * MiB;
constexpr size_t WS_ROPE = 32 * MiB;
constexpr size_t WS_H = 64 * MiB;
constexpr size_t WS_Y = WS_H;
constexpr size_t WS_PROJ = 192 * MiB;
constexpr size_t WS_END = WS_PROJ + (size_t)MROWS * 3328 * 2;

constexpr int LDS_BYTES = 147456;

__device__ __forceinline__ float wave_sum(float v) {
#pragma unroll
    for (int o = 1; o < 64; o <<= 1) v += __shfl_xor(v, o);
    return v;
}
__device__ __forceinline__ unsigned f2bf(float f) { unsigned u = __builtin_bit_cast(unsigned, f); return (u + 0x7fffu + ((u >> 16) & 1u)) >> 16; }
__device__ __forceinline__ unsigned pk2(float lo, float hi) { return cvt_pk_bf16(lo, hi); }
__device__ __forceinline__ float bf_lo(unsigned w) { return __builtin_bit_cast(float, w << 16); }
__device__ __forceinline__ float bf_hi(unsigned w) { return __builtin_bit_cast(float, w & 0xffff0000u); }

__device__ __forceinline__ void p0_transpose_item(const float* W, int K, int N, bf16_t* WT, bool headperm, LAS float* scr, int item, int lane) {
    const int nblk = N / 32, kb = item / nblk, nb = item % nblk, k0 = 64 * kb, n0 = 32 * nb;
    const int prow0 = headperm ? ((n0 & ~255) + 128 * ((n0 >> 5) & 1) + 32 * ((n0 >> 6) & 3)) : n0;
    float wv_[32];
#pragma unroll
    for (int i = 0; i < 32; ++i) wv_[i] = W[(size_t)(k0 + 2 * i + (lane >> 5)) * N + n0 + (lane & 31)];
#pragma unroll
    for (int i = 0; i < 32; ++i) scr[(2 * i + (lane >> 5)) * 33 + (lane & 31)] = wv_[i];
    __builtin_amdgcn_s_waitcnt(0xc07f); asm volatile("s_waitcnt lgkmcnt(0)" ::: "memory");
    const int c = lane & 7;
#pragma unroll
    for (int j = 0; j < 4; ++j) { const int n = (lane >> 3) + 8 * j; const LAS float* s = scr + (8 * c) * 33 + n;
        u32x4 o; o.x = pk2(s[0 * 33], s[1 * 33]); o.y = pk2(s[2 * 33], s[3 * 33]); o.z = pk2(s[4 * 33], s[5 * 33]); o.w = pk2(s[6 * 33], s[7 * 33]);
        *(u32x4*)(WT + (size_t)(prow0 + n) * K + k0 + 8 * c) = o; }
    asm volatile("s_waitcnt lgkmcnt(0)" ::: "memory");
}

__device__ __forceinline__ void p0_mod_item(const float* c, const float* w_ada, float* modp, LAS float* scr, int item, int lane) {
    const int kc = item / 48, cgp = item % 48, k0 = kc * 64, n = cgp * 64 + lane;
    float w[64];
#pragma unroll
    for (int k = 0; k < 64; ++k) w[k] = w_ada[(size_t)(k0 + k) * 3072 + n];
    {
        const int b = lane & 31, kh = lane >> 5;
        float cv_[32];
#pragma unroll
        for (int kk = 0; kk < 32; ++kk) cv_[kk] = c[b * 1024 + k0 + 2 * kk + kh];
#pragma unroll
        for (int kk = 0; kk < 32; ++kk) { const float v = cv_[kk]; scr[(2 * kk + kh) * 32 + b] = v * __builtin_amdgcn_rcpf(1.0f + __expf(-v)); }
    }
    asm volatile("s_waitcnt lgkmcnt(0)" ::: "memory");
    float acc[32];
#pragma unroll
    for (int b = 0; b < 32; ++b) acc[b] = 0.f;
#pragma unroll
    for (int k = 0; k < 64; ++k) {
#pragma unroll
        for (int b4 = 0; b4 < 8; ++b4) { const f32x4 sv = *(const LAS f32x4*)(scr + k * 32 + 4 * b4); acc[4 * b4] += sv[0] * w[k]; acc[4 * b4 + 1] += sv[1] * w[k]; acc[4 * b4 + 2] += sv[2] * w[k]; acc[4 * b4 + 3] += sv[3] * w[k]; }
    }
#pragma unroll
    for (int b = 0; b < 32; ++b) modp[((size_t)kc * 32 + b) * 3072 + n] = acc[b];
    asm volatile("s_waitcnt lgkmcnt(0)" ::: "memory");
}

__device__ __forceinline__ void p0_rope(const int* positions, float* rope, int idx, float inv_freq) {
    const int r = idx >> 5, i = idx & 31;
    const float angf = (float)positions[r] * inv_freq;
    const double a = (double)angf;
    const double nq = rint(a * 0.63661977236758134308);
    const double rr = (a - nq * 1.57079632679489655800) - nq * 6.12323399573676603587e-17;
    const double r2 = rr * rr;
    const double sn = rr * (1.0 + r2 * (-1.0 / 6 + r2 * (1.0 / 120 + r2 * (-1.0 / 5040 + r2 * (1.0 / 362880 + r2 * (-1.0 / 39916800 + r2 * (1.0 / 6227020800.0)))))));
    const double cs = 1.0 + r2 * (-0.5 + r2 * (1.0 / 24 + r2 * (-1.0 / 720 + r2 * (1.0 / 40320 + r2 * (-1.0 / 3628800 + r2 * (1.0 / 479001600 + r2 * (-1.0 / 87178291200.0)))))));
    const int q = ((int)(long long)nq) & 3;
    const double s = (q == 0) ? sn : (q == 1) ? cs : (q == 2) ? -sn : -cs;
    const double cc = (q == 0) ? cs : (q == 1) ? -sn : (q == 2) ? -cs : sn;
    rope[(size_t)r * 64 + i] = (float)cc; rope[(size_t)r * 64 + 32 + i] = (float)s;
}

struct Ptrs {
    const float *x, *c; const int* positions; const float *w_ada, *b_ada, *norm_gain, *w_in, *q_norm_a, *k_norm_a, *sink_a, *q_norm_b, *k_norm_b, *lq1, *lk1, *lq2, *lk2, *subln, *w_out;
    float* out; unsigned char* ws; int ph_lo, ph_hi;
};

__device__ __forceinline__ void phase0(const Ptrs& P, LAS unsigned char* lds, int wave, int lane) {
    LAS float* scr = (LAS float*)(lds + wave * 16384);
    const int gw = blockIdx.x * NWAVES + wave, NGW = gridDim.x * NWAVES;
    constexpr int I_MOD = 16 * 48, I_IN = (1024 / 64) * (3328 / 32), I_OUT = (1024 / 64) * (1024 / 32);
    constexpr int NITEMS = I_MOD + I_IN + I_OUT;
    float* modp = (float*)(P.ws + WS_MODP);
    const int nmodw = (NGW >= 2 * I_MOD) ? I_MOD : 0;
    if (gw < nmodw) p0_mod_item(P.c, P.w_ada, modp, scr, gw, lane);
    else {
        for (int it = gw - nmodw + (nmodw ? I_MOD : 0); it < NITEMS; it += NGW - nmodw) {
            int r = it;
            if (r < I_MOD) { p0_mod_item(P.c, P.w_ada, modp, scr, r, lane); continue; } r -= I_MOD;
            if (r < I_IN) { p0_transpose_item(P.w_in, 1024, 3328, (bf16_t*)(P.ws + WS_WIN), true, scr, r, lane); continue; } r -= I_IN;
            p0_transpose_item(P.w_out, 1024, 1024, (bf16_t*)(P.ws + WS_WOUT), false, scr, r, lane);
        }
    }
    float* rope = (float*)(P.ws + WS_ROPE);
    const float inv_freq = 1.0f / powf(10000.0f, (float)(2 * (threadIdx.x & 31)) / 64.0f);
    for (int idx = blockIdx.x * NTHREADS + threadIdx.x; idx < MROWS * 32; idx += gridDim.x * NTHREADS) p0_rope(P.positions, rope, idx, inv_freq);
}

__device__ __forceinline__ void phase1(const Ptrs& P, LAS unsigned char* lds, int wave, int lane) {
    LAS float* sh_gs = (LAS float*)lds;
    LAS float* sh_sf = (LAS float*)(lds + 4096);
    const float* modp = (const float*)(P.ws + WS_MODP);
    float* mod = (float*)(P.ws + WS_MOD);
    bf16_t* H = (bf16_t*)(P.ws + WS_H);
    for (int t = blockIdx.x; t < MROWS / 256; t += gridDim.x) {
        const int b = t >> 3;
        __syncthreads();
        for (int n = threadIdx.x; n < 3072; n += NTHREADS) {
            if (n >= 2048 && (t & 7) != 0) break;
            float s = P.b_ada[n];
#pragma unroll
            for (int kc = 0; kc < 16; ++kc) s += modp[((size_t)kc * 32 + b) * 3072 + n];
            if (n < 1024) sh_sf[n] = s;
            else if (n < 2048) sh_gs[n - 1024] = P.norm_gain[n - 1024] * (1.0f + s);
            else mod[(size_t)b * 3072 + n] = s;
        }
        __syncthreads();
        f32x4 v[4][4], vn[4][4];
        {
            const f32x4* xr = (const f32x4*)(P.x + ((size_t)t * 256 + wave * 32) * 1024) + lane;
#pragma unroll
            for (int q = 0; q < 4; ++q)
#pragma unroll
                for (int j = 0; j < 4; ++j) v[q][j] = __builtin_nontemporal_load(xr + q * 256 + 64 * j);
        }
        for (int rr = 0; rr < 32; rr += 4) {
            const size_t row = (size_t)t * 256 + wave * 32 + rr;
            if (rr + 4 < 32) {
                const f32x4* xr = (const f32x4*)(P.x + (row + 4) * 1024) + lane;
#pragma unroll
                for (int q = 0; q < 4; ++q)
#pragma unroll
                    for (int j = 0; j < 4; ++j) vn[q][j] = __builtin_nontemporal_load(xr + q * 256 + 64 * j);
            }
            float s[4];
#pragma unroll
            for (int q = 0; q < 4; ++q) { s[q] = 0.f;
#pragma unroll
                for (int j = 0; j < 4; ++j) s[q] += (v[q][j].x * v[q][j].x + v[q][j].y * v[q][j].y) + (v[q][j].z * v[q][j].z + v[q][j].w * v[q][j].w); }
#pragma unroll
            for (int o = 1; o < 64; o <<= 1) {
#pragma unroll
                for (int q = 0; q < 4; ++q) s[q] += __shfl_xor(s[q], o); }
#pragma unroll
            for (int q = 0; q < 4; ++q) {
                const float rstd = rsqrtf(s[q] * (1.f / 1024) + RMS_EPS_);
                u32x2* o8 = (u32x2*)(H + (row + q) * 1024) + lane;
#pragma unroll
                for (int j = 0; j < 4; ++j) {
                    const f32x4 g = *(const LAS f32x4*)(sh_gs + 256 * j + 4 * lane), sf = *(const LAS f32x4*)(sh_sf + 256 * j + 4 * lane);
                    const f32x4 hv = v[q][j] * rstd * g + sf;
                    u32x2 w; w.x = pk2(hv.x, hv.y); w.y = pk2(hv.z, hv.w); o8[64 * j] = w;
                }
            }
#pragma unroll
            for (int q = 0; q < 4; ++q)
#pragma unroll
                for (int j = 0; j < 4; ++j) v[q][j] = vn[q][j];
        }
    }
}

__device__ __forceinline__ unsigned off_b(unsigned row, unsigned ch) { return 256u * row + 16u * (ch ^ (((row & 3) << 2) | ((row >> 2) & 3))); }
__device__ __forceinline__ int crow(int r, int hi) { return (r & 3) + 8 * (r >> 2) + 4 * hi; }
__device__ __forceinline__ s16x4 vtr(const LAS unsigned char* p) { typedef short v4i16_t __attribute__((ext_vector_type(4))); return __builtin_bit_cast(s16x4, __builtin_amdgcn_ds_read_tr16_b64_v4i16((LAS v4i16_t*)p)); }
#define MFMA32(a, b, c) __builtin_amdgcn_mfma_f32_32x32x16_bf16((a), (b), (c), 0, 0, 0)

typedef const LAS unsigned char* ldsp_t;
__device__ __forceinline__ ldsp_t lxor(ldsp_t p, unsigned c) { return (ldsp_t)((unsigned)(uintptr_t)p ^ c); }
template <int NEB, bool MASK, bool QLDS, int KCH0, int VCH0, int QCH0>
__device__ __forceinline__ void att_half(ldsp_t kaddr, ldsp_t vaddr, ldsp_t qaddr, const bf16x8 (&qf)[4], f32x16 (&o)[NEB], float& l, float negm, int hi, int dq0  ) {
    f32x16 s;
#pragma unroll
    for (int i = 0; i < 16; ++i) s[i] = negm;
#pragma unroll
    for (int ks = 0; ks < 4; ++ks) {
        const bf16x8 kf = *(const LAS bf16x8*)lxor(kaddr, 16u * (KCH0 + 2 * ks));
        bf16x8 qv;
        if (QLDS) qv = *(const LAS bf16x8*)lxor(qaddr, 16u * (QCH0 + 2 * ks)); else qv = qf[ks];
        s = MFMA32(kf, qv, s);
    }
    float sum = 0.f;
#pragma unroll
    for (int i = 0; i < 16; ++i) {
        float p = __builtin_amdgcn_exp2f(s[i]);
        if (MASK) { const int d = dq0 - crow(i, hi); p = (d <= 128 && d >= -128) ? p : 0.f; }
        s[i] = p; sum += p;
    }
    l += sum;
    u32x4 w0, w1;
    w0.x = cvt_pk_bf16(s[0], s[1]); w0.y = cvt_pk_bf16(s[2], s[3]); w0.z = cvt_pk_bf16(s[4], s[5]); w0.w = cvt_pk_bf16(s[6], s[7]);
    w1.x = cvt_pk_bf16(s[8], s[9]); w1.y = cvt_pk_bf16(s[10], s[11]); w1.z = cvt_pk_bf16(s[12], s[13]); w1.w = cvt_pk_bf16(s[14], s[15]);
    const bf16x8 pk0 = __builtin_bit_cast(bf16x8, w0), pk1 = __builtin_bit_cast(bf16x8, w1);
#pragma unroll
    for (int eb = 0; eb < NEB; ++eb) {
        const ldsp_t a0 = lxor(vaddr, 64u * (VCH0 / 4 + eb)), a1 = lxor(vaddr, (64u * (VCH0 / 4 + eb)) ^ 32u);
#pragma unroll
        for (int u = 0; u < 2; ++u) {
            const s16x4 lo = vtr(a0 + 4096 * u);
            const s16x4 hh = vtr(a1 + 4096 * u + 2048);
            const bf16x8 vf = (bf16x8){lo[0], lo[1], lo[2], lo[3], hh[0], hh[1], hh[2], hh[3]};
            o[eb] = MFMA32(vf, u == 0 ? pk0 : pk1, o[eb]);
        }
    }
}
__device__ __forceinline__ unsigned lane_kL(int r32, int hi) { const unsigned xk = ((r32 & 3) << 2) | ((r32 >> 2) & 3); return 256u * r32 + 16u * ((unsigned)hi ^ xk); }
__device__ __forceinline__ unsigned lane_vL(int lane, int hi) { const unsigned blk = (lane >> 4) & 1, q = (lane & 15) >> 2, p = lane & 3; return 256u * (4 * hi + q) + 64u * q + ((32u * blk + 16u * (p >> 1)) ^ (16u * hi)) + 8u * (p & 1); }

__device__ __forceinline__ void glds16(const void* gsrc, unsigned lds_dst) { unsigned keep;
    asm volatile("s_mov_b32 %0, m0\n\ts_mov_b32 m0, %2\n\ts_nop 0\n\tglobal_load_lds_dwordx4 %1, off\n\ts_mov_b32 m0, %0" : "=&s"(keep) : "v"(gsrc), "s"(lds_dst) : "memory"); }
__device__ __forceinline__ f32x16 qk_half(ldsp_t kaddr, const bf16x8 (&qf)[4], float negm) {
    f32x16 s;
#pragma unroll
    for (int i = 0; i < 16; ++i) s[i] = negm;
#pragma unroll
    for (int ks = 0; ks < 4; ++ks) { const bf16x8 kf = *(const LAS bf16x8*)lxor(kaddr, 32u * ks); s = MFMA32(kf, qf[ks], s); }
    return s;
}
__device__ __forceinline__ void exp_pack(f32x16& s, float& l, bf16x8& pk0, bf16x8& pk1) {
    float sum = 0.f;
#pragma unroll
    for (int i = 0; i < 16; ++i) { s[i] = __builtin_amdgcn_exp2f(s[i]); sum += s[i]; }
    l += sum;
    u32x4 w0, w1;
    w0.x = cvt_pk_bf16(s[0], s[1]); w0.y = cvt_pk_bf16(s[2], s[3]); w0.z = cvt_pk_bf16(s[4], s[5]); w0.w = cvt_pk_bf16(s[6], s[7]);
    w1.x = cvt_pk_bf16(s[8], s[9]); w1.y = cvt_pk_bf16(s[10], s[11]); w1.z = cvt_pk_bf16(s[12], s[13]); w1.w = cvt_pk_bf16(s[14], s[15]);
    pk0 = __builtin_bit_cast(bf16x8, w0); pk1 = __builtin_bit_cast(bf16x8, w1);
}
template <int NEB, int VB = 0>
__device__ __forceinline__ void pv_half(ldsp_t vaddr, const bf16x8 pk0, const bf16x8 pk1, f32x16 (&o)[NEB]) {
#pragma unroll
    for (int eb = 0; eb < NEB; ++eb) {
        const ldsp_t a0 = lxor(vaddr, 64u * (VB + eb)), a1 = lxor(vaddr, (64u * (VB + eb)) ^ 32u);
#pragma unroll
        for (int u = 0; u < 2; ++u) {
            const s16x4 lo = vtr(a0 + 4096 * u);
            const s16x4 hh = vtr(a1 + 4096 * u + 2048);
            const bf16x8 vf = (bf16x8){lo[0], lo[1], lo[2], lo[3], hh[0], hh[1], hh[2], hh[3]};
            o[eb] = MFMA32(vf, u == 0 ? pk0 : pk1, o[eb]);
        }
    }
}

__device__ __forceinline__ void attnB_stream(LAS unsigned char* lds, const bf16_t* proj, bf16_t* y, const float* subln, int u0, int ustride, int nunits, float negm, float lam) {
    const int tid = threadIdx.x, lane = tid & 63, wid = __builtin_amdgcn_readfirstlane(tid >> 6), r32 = lane & 31, hi = lane >> 5;
    const int c = wid >> 2, rg = wid & 3;
    const int img = wid >> 2;
    unsigned goff[4];
#pragma unroll
    for (int i = 0; i < 4; ++i) goff[i] = (unsigned)((16 * (wid & 3) + 4 * i + (lane >> 4)) * PROJ_W + 8 * ((lane & 15) ^ (((lane >> 4) << 2) | i))) * 2u;
    const unsigned dst0 = img * 16384 + (4 * (wid & 3)) * 1024;
    const unsigned ldsbase = (unsigned)(uintptr_t)lds;
#define UNIT_GSRC(u) ((const char*)(proj + (size_t)((u) >> 6) * SEQ * PROJ_W + (img ? C_VB : C_KB) + 128 * (((u) >> 4) & 3)))
#define DMA_TILE(gs0, t, bufoff) do { const char* gs_ = (gs0) + (size_t)(t) * (64 * PROJ_W * 2); _Pragma("unroll") for (int i_ = 0; i_ < 4; ++i_) \
        glds16(gs_ + goff[i_], (unsigned)__builtin_amdgcn_readfirstlane(ldsbase + (bufoff) + dst0 + i_ * 1024)); } while (0)
#define LOAD_Q(u) do { const bf16_t* qp_ = proj + ((size_t)((u) >> 6) * SEQ + ((u) & 15) * 128 + rg * 32 + r32) * PROJ_W + C_QB + 128 * (((u) >> 4) & 3) + 64 * c + 8 * hi; \
        _Pragma("unroll") for (int s_ = 0; s_ < 4; ++s_) qf[s_] = *(const bf16x8*)(qp_ + 16 * s_); } while (0)
    LAS float* sh_gain = (LAS float*)(lds + 131072 + 2048);
    if (tid < 128) sh_gain[tid] = subln[tid];
    if (u0 >= nunits) return;
    int b0 = 0, b1 = 32768, b2 = 65536;
    bf16x8 qf[4];
    { const char* g0 = UNIT_GSRC(u0); DMA_TILE(g0, 0, b0); DMA_TILE(g0, 1, b1); LOAD_Q(u0); }
    unsigned kL = lane_kL(r32, hi) ^ (128u * c), vL = lane_vL(lane, hi);
    for (int u = u0; u < nunits; u += ustride) {
        const int un = u + ustride; const bool has_next = un < nunits;
        const char* gcur = UNIT_GSRC(u); const char* gnxt = UNIT_GSRC(has_next ? un : u);
        const int qb = u & 15, h = (u >> 4) & 3, b = u >> 6;
        const size_t qrow = (size_t)b * SEQ + qb * 128 + rg * 32 + r32;
        f32x16 o[4];
#pragma unroll
        for (int e = 0; e < 4; ++e)
#pragma unroll
            for (int i = 0; i < 16; ++i) o[e][i] = 0.f;
        float l = 0.f;
        if (u == u0) asm volatile("s_waitcnt vmcnt(0)" ::: "memory");
        __syncthreads();
#define SB_STAGE() __builtin_amdgcn_sched_barrier(0x2 | 0x4 | 0x400)
#define KLOAD(dst, base) do { _Pragma("unroll") for (int ks_ = 0; ks_ < 4; ++ks_) dst[ks_] = *(const LAS bf16x8*)lxor((base), 32u * ks_); } while (0)
#define VLOAD(dst, base, eb0) do { _Pragma("unroll") for (int e_ = 0; e_ < 2; ++e_) { const ldsp_t a0_ = lxor((base), 64u * ((eb0) + e_)), a1_ = lxor((base), (64u * ((eb0) + e_)) ^ 32u); \
            _Pragma("unroll") for (int u_ = 0; u_ < 2; ++u_) { const s16x4 lo_ = vtr(a0_ + 4096 * u_); const s16x4 hh_ = vtr(a1_ + 4096 * u_ + 2048); \
                dst[e_][u_] = (bf16x8){lo_[0], lo_[1], lo_[2], lo_[3], hh_[0], hh_[1], hh_[2], hh_[3]}; } } } while (0)
#define QKMMA(sd, kf) do { _Pragma("unroll") for (int ks_ = 0; ks_ < 4; ++ks_) sd = MFMA32(kf[ks_], qf[ks_], ks_ == 0 ? negv : sd); } while (0)
#define PVMMA(vf, eb0, p0, p1) do { _Pragma("unroll") for (int e_ = 0; e_ < 2; ++e_) { o[(eb0) + e_] = MFMA32(vf[e_][0], p0, o[(eb0) + e_]); o[(eb0) + e_] = MFMA32(vf[e_][1], p1, o[(eb0) + e_]); } } while (0)
        f32x16 negv;
#pragma unroll
        for (int i = 0; i < 16; ++i) negv[i] = negm;
        asm volatile("" : "+v"(negv));
        bf16x8 kfa[4], kfb[4], vfa[2][2], vfb[2][2], pa, pb, pc, pd;
        f32x16 s0, s1;
        KLOAD(kfa, lds + b0 + kL);
        KLOAD(kfb, lds + b0 + 8192 + kL);
        QKMMA(s0, kfa);
        for (int t = 0; t < 32; ++t) {
            asm volatile("" : "+v"(kL), "+v"(vL));
            if (t + 2 < 32) DMA_TILE(gcur, t + 2, b2); else if (has_next) DMA_TILE(gnxt, t - 30, b2);
            ldsp_t vb = lds + b0 + 16384 + vL, kn = lds + b1 + kL;
            VLOAD(vfa, vb, 0);
            QKMMA(s1, kfb);
            exp_pack(s0, l, pa, pb);
            SB_STAGE();
            VLOAD(vfb, vb, 2);
            PVMMA(vfa, 0, pa, pb);
            SB_STAGE();
            KLOAD(kfa, kn);
            PVMMA(vfb, 2, pa, pb);
            exp_pack(s1, l, pc, pd);
            SB_STAGE();
            VLOAD(vfa, vb + 8192, 0);
            QKMMA(s0, kfa);
            SB_STAGE();
            VLOAD(vfb, vb + 8192, 2);
            PVMMA(vfa, 0, pc, pd);
            SB_STAGE();
            KLOAD(kfb, kn + 8192);
            PVMMA(vfb, 2, pc, pd);
            asm volatile("s_waitcnt vmcnt(0)" ::: "memory");
            __syncthreads();
            const int tmp = b0; b0 = b1; b1 = b2; b2 = tmp;
        }
#undef SB_STAGE
#undef KLOAD
#undef VLOAD
#undef QKMMA
#undef PVMMA
        if (has_next) LOAD_Q(un);
        l += __shfl_xor(l, 32);
        LAS float* xch = (LAS float*)(lds + (rg < 2 ? b2 + rg * 16384 : 98304 + (rg - 2) * 16384)) + r32;
        const bf16_t* gp = proj + qrow * PROJ_W + C_GB + 128 * h + 8 * hi;
        if (c == 1) {
            const float i1 = lam / l;
#pragma unroll
            for (int e = 0; e < 4; ++e)
#pragma unroll
                for (int i = 0; i < 16; ++i) xch[(32 * e + crow(i, hi)) * 32] = o[e][i] * i1;
        }
        __syncthreads();
        if (c == 0) {
            u32x4 gc[2], gn2[2];
#pragma unroll
            for (int k = 0; k < 2; ++k) gc[k] = *(const u32x4*)(gp + 16 * k);
            const float i0 = 1.0f / l;
            float ss = 0.f;
#pragma unroll
            for (int e = 0; e < 4; ++e)
#pragma unroll
                for (int i = 0; i < 16; ++i) { const float v = o[e][i] * i0 - xch[(32 * e + crow(i, hi)) * 32]; o[e][i] = v; ss += v * v; }
            ss += __shfl_xor(ss, 32);
            const float rstd = rsqrtf(ss * (1.0f / 128.0f) + RMS_EPS_) * (1.0f - LAMBDA_INIT);
            bf16_t* yp16 = y + qrow * 1024 + 512 + 128 * h + 8 * hi;
#pragma unroll
            for (int e = 0; e < 4; ++e) {
                if (e < 3) {
#pragma unroll
                    for (int k = 0; k < 2; ++k) gn2[k] = *(const u32x4*)(gp + 32 * (e + 1) + 16 * k);
                }
#pragma unroll
                for (int k = 0; k < 2; ++k) {
                    float lo4[4], hi4[4];
#pragma unroll
                    for (int j = 0; j < 4; ++j) {
                        const auto r = __builtin_amdgcn_permlane32_swap(__float_as_uint(o[e][8 * k + j]), __float_as_uint(o[e][8 * k + 4 + j]), false, false);
                        lo4[j] = __uint_as_float(r[0]); hi4[j] = __uint_as_float(r[1]);
                    }
                    const f32x4 ga = *(const LAS f32x4*)(sh_gain + 32 * e + 16 * k + 8 * hi), gb = *(const LAS f32x4*)(sh_gain + 32 * e + 16 * k + 8 * hi + 4);
                    const u32x4 g4v = gc[k];
                    u32x4 w4;
                    w4.x = pk2(lo4[0] * rstd * ga[0] * bf_lo(g4v.x), lo4[1] * rstd * ga[1] * bf_hi(g4v.x)); w4.y = pk2(lo4[2] * rstd * ga[2] * bf_lo(g4v.y), lo4[3] * rstd * ga[3] * bf_hi(g4v.y));
                    w4.z = pk2(hi4[0] * rstd * gb[0] * bf_lo(g4v.z), hi4[1] * rstd * gb[1] * bf_hi(g4v.z)); w4.w = pk2(hi4[2] * rstd * gb[2] * bf_lo(g4v.w), hi4[3] * rstd * gb[3] * bf_hi(g4v.w));
                    *(u32x4*)(yp16 + 32 * e + 16 * k) = w4;
                }
#pragma unroll
                for (int k = 0; k < 2; ++k) gc[k] = gn2[k];
                asm volatile("" ::: "memory");
            }
        }
    }
#undef DMA_TILE
#undef UNIT_GSRC
#undef LOAD_Q
    __syncthreads();
}

__device__ __forceinline__ void attnA_strip(LAS unsigned char* lds, const bf16_t* proj, bf16_t* y, const float* sink, int b, int kvh, int qb0, int nq, float negm) {
    const int tid = threadIdx.x, lane = tid & 63, wid = __builtin_amdgcn_readfirstlane(tid >> 6), r32 = lane & 31, hi = lane >> 5;
    const size_t rowbase = (size_t)b * SEQ;
    const char* gsrc = (const char*)(proj + rowbase * PROJ_W);
    unsigned goff[2];
#pragma unroll
    for (int j = 0; j < 2; ++j) {
        const int blk = 2 * wid + j, row = 4 * blk + (lane >> 4);
        const int ch = (lane & 15) ^ (((lane >> 4) << 2) | (blk & 3));
        const int col = (ch < 8) ? (C_KA + 64 * kvh + 8 * ch) : (C_VA + 64 * kvh + 8 * (ch - 8));
        goff[j] = (unsigned)(row * PROJ_W + col) * 2u;
    }
    const unsigned ldsbase = (unsigned)(uintptr_t)lds;
#define DMA_TILE_A(kt) do { if ((kt) >= 0 && (kt) < 32) { const char* gs_ = gsrc + (size_t)(kt) * (64 * PROJ_W * 2); const unsigned so_ = ((kt) % 6) * 16384 + 2 * wid * 1024; \
        glds16(gs_ + goff[0], (unsigned)__builtin_amdgcn_readfirstlane(ldsbase + so_)); glds16(gs_ + goff[1], (unsigned)__builtin_amdgcn_readfirstlane(ldsbase + so_ + 1024)); } } while (0)
    for (int kt = qb0 - 2; kt <= qb0 + 2; ++kt) DMA_TILE_A(kt);
    const int g = wid & 3, rg = wid >> 2, head = 4 * kvh + g;
    const float sinkv = __builtin_amdgcn_exp2f(sink[head] * LOG2E + negm);
    unsigned kL = lane_kL(r32, hi), vL = lane_vL(lane, hi);
    bf16x8 qf[4];
    {
        const bf16_t* qp = proj + (rowbase + 64 * qb0 + 32 * rg + r32) * PROJ_W + C_QA + 64 * head + 8 * hi;
#pragma unroll
        for (int s = 0; s < 4; ++s) qf[s] = *(const bf16x8*)(qp + 16 * s);
    }
    for (int iq = 0; iq < nq; ++iq) {
        const int qb = qb0 + iq;
        const int qpos = 64 * qb + 32 * rg + r32;
        const size_t qrow = rowbase + qpos;
        f32x16 o[2];
#pragma unroll
        for (int e = 0; e < 2; ++e)
#pragma unroll
            for (int i = 0; i < 16; ++i) o[e][i] = 0.f;
        float l = 0.f;
        if (iq == 0) asm volatile("s_waitcnt vmcnt(0)" ::: "memory"); else asm volatile("s_waitcnt vmcnt(8)" ::: "memory");
        __syncthreads();
        if (iq + 1 < nq) DMA_TILE_A(qb + 3);
        const bf16_t* gp = proj + qrow * PROJ_W + C_GA + 64 * head + 8 * hi;
        u32x4 gt[2][2];
#pragma unroll
        for (int e = 0; e < 2; ++e)
#pragma unroll
            for (int k = 0; k < 2; ++k) gt[e][k] = *(const u32x4*)(gp + 32 * e + 16 * k);
        bf16x8 qn[4];
        {
            const bf16_t* qp = proj + (qrow + ((iq + 1 < nq) ? 64 : 0)) * PROJ_W + C_QA + 64 * head + 8 * hi;
#pragma unroll
            for (int s = 0; s < 4; ++s) qn[s] = *(const bf16x8*)(qp + 16 * s);
        }
        const int qw0 = 64 * qb + 32 * rg;
        const int i_lo = (qw0 - 128 < 0) ? ((128 - qw0) >> 5) : 0;
        const int i_hi = (qw0 + 128 > SEQ - 32) ? ((SEQ - 32 - qw0 + 128) >> 5) : 8;
#define HALF_IMG(i) (lds + (((qw0 - 128 + 32 * (i)) >> 6) % 6) * 16384 + (((qw0 - 128 + 32 * (i)) >> 5) & 1) * 8192)
#define KLOAD_A(dst, base) do { _Pragma("unroll") for (int ks_ = 0; ks_ < 4; ++ks_) dst[ks_] = *(const LAS bf16x8*)lxor((base), 32u * ks_); } while (0)
#define QK_A(sd, kf) do { _Pragma("unroll") for (int ks_ = 0; ks_ < 4; ++ks_) sd = MFMA32(kf[ks_], qf[ks_], ks_ == 0 ? negv : sd); } while (0)
        f32x16 negv;
#pragma unroll
        for (int r = 0; r < 16; ++r) negv[r] = negm;
        asm volatile("" : "+v"(negv));
        bf16x8 kfn[4], vf[2][2];
        f32x16 sc, sn;
#define A_STEP(MASKED) do { \
            const int n1_ = (i + 2 < i_hi) ? i + 2 : i_hi; \
            ldsp_t va_ = HALF_IMG(i) + vL; \
            _Pragma("unroll") for (int eb = 0; eb < 2; ++eb) { const ldsp_t a0 = lxor(va_, 64u * (2 + eb)), a1 = lxor(va_, (64u * (2 + eb)) ^ 32u); \
                _Pragma("unroll") for (int u = 0; u < 2; ++u) { const s16x4 lo = vtr(a0 + 4096 * u); const s16x4 hh = vtr(a1 + 4096 * u + 2048); vf[eb][u] = (bf16x8){lo[0], lo[1], lo[2], lo[3], hh[0], hh[1], hh[2], hh[3]}; } } \
            QK_A(sn, kfn); \
            __builtin_amdgcn_sched_barrier(0x2 | 0x4 | 0x400); \
            KLOAD_A(kfn, HALF_IMG(n1_) + kL); \
            _Pragma("unroll") for (int r = 0; r < 16; ++r) sc[r] = __builtin_amdgcn_exp2f(sc[r]); \
            if (MASKED) { const int dq0 = qpos - (qw0 - 128 + 32 * i); \
                _Pragma("unroll") for (int r = 0; r < 16; ++r) { const int d = dq0 - crow(r, hi); sc[r] = (d <= 128 && d >= -128) ? sc[r] : 0.f; } } \
            float sum = 0.f; \
            _Pragma("unroll") for (int r = 0; r < 16; ++r) sum += sc[r]; \
            l += sum; \
            u32x4 w0, w1; \
            w0.x = cvt_pk_bf16(sc[0], sc[1]); w0.y = cvt_pk_bf16(sc[2], sc[3]); w0.z = cvt_pk_bf16(sc[4], sc[5]); w0.w = cvt_pk_bf16(sc[6], sc[7]); \
            w1.x = cvt_pk_bf16(sc[8], sc[9]); w1.y = cvt_pk_bf16(sc[10], sc[11]); w1.z = cvt_pk_bf16(sc[12], sc[13]); w1.w = cvt_pk_bf16(sc[14], sc[15]); \
            const bf16x8 pk0 = __builtin_bit_cast(bf16x8, w0), pk1 = __builtin_bit_cast(bf16x8, w1); \
            _Pragma("unroll") for (int eb = 0; eb < 2; ++eb) { o[eb] = MFMA32(vf[eb][0], pk0, o[eb]); o[eb] = MFMA32(vf[eb][1], pk1, o[eb]); } \
            sc = sn; } while (0)
        KLOAD_A(kfn, HALF_IMG(i_lo) + kL);
        QK_A(sc, kfn);
        KLOAD_A(kfn, HALF_IMG((i_lo + 1 < i_hi) ? i_lo + 1 : i_hi) + kL);
        int i = i_lo;
        if (i == 0) { A_STEP(true); ++i; }
        const int i_end = (i_hi == 8) ? 7 : i_hi;
#pragma unroll 2
        for (; i <= i_end; ++i) A_STEP(false);
        if (i_hi == 8) A_STEP(true);
#undef A_STEP
#undef KLOAD_A
#undef QK_A
#undef HALF_IMG
        l += __shfl_xor(l, 32);
        l += sinkv;
        const float inv = 1.0f / l;
        bf16_t* yp16 = y + qrow * 1024 + 64 * head + 8 * hi;
#pragma unroll
        for (int e = 0; e < 2; ++e)
#pragma unroll
            for (int k = 0; k < 2; ++k) {
                float lo4[4], hi4[4];
#pragma unroll
                for (int j = 0; j < 4; ++j) {
                    const auto r = __builtin_amdgcn_permlane32_swap(__float_as_uint(o[e][8 * k + j]), __float_as_uint(o[e][8 * k + 4 + j]), false, false);
                    lo4[j] = __uint_as_float(r[0]); hi4[j] = __uint_as_float(r[1]);
                }
                const u32x4 g4v = gt[e][k];
                u32x4 w4;
                w4.x = pk2(lo4[0] * inv * bf_lo(g4v.x), lo4[1] * inv * bf_hi(g4v.x)); w4.y = pk2(lo4[2] * inv * bf_lo(g4v.y), lo4[3] * inv * bf_hi(g4v.y));
                w4.z = pk2(hi4[0] * inv * bf_lo(g4v.z), hi4[1] * inv * bf_hi(g4v.z)); w4.w = pk2(hi4[2] * inv * bf_lo(g4v.w), hi4[3] * inv * bf_hi(g4v.w));
                *(u32x4*)(yp16 + 32 * e + 16 * k) = w4;
            }
#pragma unroll
        for (int s = 0; s < 4; ++s) qf[s] = qn[s];
    }
#undef DMA_TILE_A
    __syncthreads();
}

__device__ __forceinline__ float absmax64(const float* g) { float m = 0.f; for (int i = 0; i < 64; ++i) m = fmaxf(m, fabsf(g[i])); return m; }

__device__ __forceinline__ void phase3(const Ptrs& P, LAS unsigned char* lds) {
    const bf16_t* proj = (const bf16_t*)(P.ws + WS_PROJ);
    bf16_t* y = (bf16_t*)(P.ws + WS_Y);
    const float negmA = -(8.0f * absmax64(P.q_norm_a) * absmax64(P.k_norm_a)) * LOG2E;
    const float negmB = -(8.0f * absmax64(P.q_norm_b) * absmax64(P.k_norm_b)) * LOG2E;
    float d1 = 0.f, d2 = 0.f;
    for (int i = 0; i < 64; ++i) { d1 += P.lq1[i] * P.lk1[i]; d2 += P.lq2[i] * P.lk2[i]; }
    const float lam = expf(d1) - expf(d2) + LAMBDA_INIT;
    const int vblk = ((gridDim.x & 7) == 0) ? (int)((blockIdx.x & 7) * (gridDim.x >> 3) + (blockIdx.x >> 3)) : (int)blockIdx.x;
#ifndef NO_ATTB
    for (int rep = 0; rep < REP3B; ++rep) attnB_stream(lds, proj, y, P.subln, vblk, (int)gridDim.x, BATCH * 4 * 16, negmB, lam);
#endif
    __syncthreads();
#ifndef NO_ATTA
    for (int rep = 0; rep < REP3A; ++rep)
    for (int st = vblk; st < BATCH * 2 * 4; st += gridDim.x) {
        const int q8 = st & 3, kvh = (st >> 2) & 1, b = st >> 3;
        attnA_strip(lds, proj, y, P.sink_a, b, kvh, 8 * q8, 8, negmA);
    }
#endif
}

#define XB_TMO      128
#define XB_XCNT(j)  (256  + 64 * (j))
#define XB_XSUB(j)  (1280 + 64 * (j))
#define XB_XGEN(j)  (2304 + 64 * (j))
#define XB_TOP      3328
#define XB_TOPGEN   3392
#define XCD_BAR_WORDS 3456
#define XB_SPIN_CAP (1u << 18)

__device__ __forceinline__ unsigned xb_ld(unsigned* p)              { return __hip_atomic_load(p, __ATOMIC_RELAXED, __HIP_MEMORY_SCOPE_AGENT); }
__device__ __forceinline__ unsigned xb_add(unsigned* p, unsigned v) { return __hip_atomic_fetch_add(p, v, __ATOMIC_RELAXED, __HIP_MEMORY_SCOPE_AGENT); }
__device__ __forceinline__ unsigned xb_xcc_id() { return (unsigned)__builtin_amdgcn_s_getreg((3 << 11) | 20) & 0xFu; }
#define XB_SPIN(cond, bar) do { unsigned _sp = 0; while (cond) { __builtin_amdgcn_s_sleep(1); \
    if ((++_sp & 255u) == 0u) { if (xb_ld(&(bar)[XB_TMO])) break; if (_sp > XB_SPIN_CAP) { atomicAdd(&(bar)[XB_TMO], 1u); break; } } } } while (0)

struct XcdBarrier {
    unsigned* bar; unsigned x;
    volatile LAS unsigned* st;
};

__device__ __forceinline__ XcdBarrier xcd_barrier_post(unsigned* bar, volatile LAS unsigned* st) {
    XcdBarrier b; b.bar = bar; b.x = xb_xcc_id(); b.st = st;
    if (threadIdx.x == 0) (void)xb_add(&bar[XB_XCNT(b.x)], 1u);
    return b;
}
__device__ __forceinline__ void xcd_barrier_complete(unsigned* bar, unsigned x, unsigned& nloc, unsigned& nx) {
    const unsigned G = gridDim.x * gridDim.y * gridDim.z;
    unsigned sum, cnt, mine, sp = 0u;
    for (;;) {
        sum = 0u; cnt = 0u; mine = 0u;
#pragma unroll
        for (unsigned j = 0; j < 16; ++j) { const unsigned c = xb_ld(&bar[XB_XCNT(j)]); sum += c; cnt += (c > 0u) ? 1u : 0u; mine = (j == x) ? c : mine; }
        if (sum == G) break;
        __builtin_amdgcn_s_sleep(1);
        if ((++sp & 255u) == 0u) { if (xb_ld(&bar[XB_TMO])) break; if (sp > XB_SPIN_CAP) { atomicAdd(&bar[XB_TMO], 1u); break; } }
    }
    nloc = mine > 0u ? mine : 1u; nx = cnt > 0u ? cnt : 1u;
}

__device__ __forceinline__ void xcd_barrier(const XcdBarrier& b) {
    asm volatile("s_waitcnt vmcnt(0)" ::: "memory");
    __syncthreads();
    if (threadIdx.x == 0) {
        unsigned* bar = b.bar;
        __builtin_amdgcn_s_waitcnt(0);
        unsigned nloc = b.st[0], nx = b.st[1];
        if (nloc == 0u) { xcd_barrier_complete(bar, b.x, nloc, nx); b.st[0] = nloc; b.st[1] = nx; }
        const unsigned old = xb_add(&bar[XB_XSUB(b.x)], 1u);
        const unsigned gen = old / nloc;
        if (old + 1u == (gen + 1u) * nloc) {
            __builtin_amdgcn_fence(__ATOMIC_RELEASE, "agent");
            asm volatile("s_waitcnt vmcnt(0)" ::: "memory");
            const unsigned og = xb_add(&bar[XB_TOP], 1u);
            const unsigned tg = og / nx;
            if (og + 1u == (tg + 1u) * nx) xb_add(&bar[XB_TOPGEN], 1u);
            else XB_SPIN(xb_ld(&bar[XB_TOPGEN]) == tg, bar);
            __builtin_amdgcn_fence(__ATOMIC_ACQUIRE, "agent");
            xb_add(&bar[XB_XGEN(b.x)], 1u);
            asm volatile("s_waitcnt vmcnt(0)" ::: "memory");
        } else {
            XB_SPIN(xb_ld(&bar[XB_XGEN(b.x)]) == gen, bar);
            __builtin_amdgcn_fence(__ATOMIC_ACQUIRE, "agent");
            asm volatile("s_waitcnt vmcnt(0)" ::: "memory");
        }
    }
    __syncthreads();
}

__global__ void __launch_bounds__(NTHREADS) hymba_fwd(Ptrs P) {
    extern __shared__ __attribute__((aligned(1024))) unsigned char lds_raw[];
    LAS unsigned char* lds = (LAS unsigned char*)lds_raw;
    cg::grid_group grid = cg::this_grid();
    const int lane = threadIdx.x & 63, wave = __builtin_amdgcn_readfirstlane(threadIdx.x >> 6);
    const int lo = P.ph_lo, hi = P.ph_hi;
    if (lo < 0) grid.sync();
    volatile LAS unsigned* bar_st = (volatile LAS unsigned*)(lds + 131072 + 1024);
    if (threadIdx.x < 2) bar_st[threadIdx.x] = 0u;
    __syncthreads();
    XcdBarrier bar = xcd_barrier_post((unsigned*)(P.ws + WS_CTL), bar_st);
#ifndef PHMASK
#define PHMASK 31
#endif
#define IN(k) (((PHMASK >> (k)) & 1) && lo <= (k) && (k) < hi)
#define SEAM(k) do { if (IN(k) && IN((k) + 1)) xcd_barrier(bar); } while (0)
    if (IN(0)) for (int rep = 0; rep < REP0; ++rep) phase0(P, lds, wave, lane);
    SEAM(0);
    if (IN(1)) for (int rep = 0; rep < REP1; ++rep) phase1(P, lds, wave, lane);
    SEAM(1);
    if (IN(2)) {
        __syncthreads();
        pg8::Gemm g{(const bf16_t*)(P.ws + WS_H), (const bf16_t*)(P.ws + WS_WIN), MROWS, 3328, 1024};
        pg8::StaticOrder S; S.init(MROWS, 3328, gridDim.x, (int)blockIdx.x, WGM_G1);
        pg8::EpiProj E{(bf16_t*)(P.ws + WS_PROJ), (const float*)(P.ws + WS_ROPE), P.q_norm_a, P.k_norm_a, P.q_norm_b, P.k_norm_b};
        pg8::gemm_phase<pg8::EpiProj, pg8::StaticOrder, true, true>(lds, g, S, E);
#if REP2 == 2
        __syncthreads();
        pg8::gemm_phase<pg8::EpiProj, pg8::StaticOrder, true, true>(lds, g, S, E);
#endif
    }
    SEAM(2);
    if (IN(3)) { __syncthreads(); phase3(P, lds); }
    SEAM(3);
    if (IN(4)) {
        __syncthreads();
        pg8::Gemm g{(const bf16_t*)(P.ws + WS_Y), (const bf16_t*)(P.ws + WS_WOUT), MROWS, 1024, 1024};
        pg8::StaticOrder S; S.init(MROWS, 1024, gridDim.x, (int)blockIdx.x, WGM_G2);
        pg8::EpiOut E{P.x, P.out, (const float*)(P.ws + WS_MOD) + 2048};
        pg8::gemm_phase<pg8::EpiOut, pg8::StaticOrder, true, true>(lds, g, S, E);
#if REP4 == 2
        __syncthreads();
        pg8::gemm_phase<pg8::EpiOut, pg8::StaticOrder, true, true>(lds, g, S, E);
#endif
    }
#undef IN
#undef SEAM
}

#ifndef MK_N_LAUNCHES
#define MK_N_LAUNCHES 1
#endif

extern "C" void kernel_launch(void* const* d_in, const int* in_sizes, int n_in, void* d_out, int out_size, void* d_ws, size_t ws_size, hipStream_t stream) {
    static int grid = 0;
    if (grid == 0) {
        if (n_in != 18 || ws_size < WS_END) { fprintf(stderr, "kernel_launch: unexpected n_in %d / ws_size %zu\n", n_in, ws_size); grid = -1; return; }
        int dev = 0, cus = 0, per_cu = 0;
        hipGetDevice(&dev);
        hipDeviceGetAttribute(&cus, hipDeviceAttributeMultiprocessorCount, dev);
        if (hipFuncSetAttribute((const void*)hymba_fwd, hipFuncAttributeMaxDynamicSharedMemorySize, LDS_BYTES) != hipSuccess) { fprintf(stderr, "kernel_launch: hipFuncSetAttribute failed\n"); grid = -1; return; }
        if (hipOccupancyMaxActiveBlocksPerMultiprocessor(&per_cu, (const void*)hymba_fwd, NTHREADS, LDS_BYTES) != hipSuccess || per_cu < 1) { fprintf(stderr, "kernel_launch: occupancy query says %d blocks/CU\n", per_cu); (void)hipGetLastError(); grid = -1; return; }
        grid = cus * per_cu;
        if (grid > 256) grid = 256;
    }
    if (grid < 0) return;
    if (hipMemsetAsync((char*)d_ws + WS_CTL, 0, CTL_BYTES, stream) != hipSuccess) { fprintf(stderr, "kernel_launch: memset of the barrier words failed\n"); return; }
    Ptrs p{};
    p.x = (const float*)d_in[0]; p.c = (const float*)d_in[1]; p.positions = (const int*)d_in[2]; p.w_ada = (const float*)d_in[3]; p.b_ada = (const float*)d_in[4];
    p.norm_gain = (const float*)d_in[5]; p.w_in = (const float*)d_in[6]; p.q_norm_a = (const float*)d_in[7]; p.k_norm_a = (const float*)d_in[8]; p.sink_a = (const float*)d_in[9];
    p.q_norm_b = (const float*)d_in[10]; p.k_norm_b = (const float*)d_in[11]; p.lq1 = (const float*)d_in[12]; p.lk1 = (const float*)d_in[13]; p.lq2 = (const float*)d_in[14];
    p.lk2 = (const float*)d_in[15]; p.subln = (const float*)d_in[16]; p.w_out = (const float*)d_in[17];
    p.out = (float*)d_out; p.ws = (unsigned char*)d_ws;
#if MK_N_LAUNCHES == 1
    p.ph_lo = 0; p.ph_hi = 5;
    void* args[] = {&p};
    hipError_t e = hipLaunchCooperativeKernel((const void*)hymba_fwd, dim3(grid), dim3(NTHREADS), args, LDS_BYTES, stream);
    if (e != hipSuccess) fprintf(stderr, "cooperative launch failed: %s (grid %d)\n", hipGetErrorString(e), grid);
#else
    for (int k = 0; k < 5; ++k) { p.ph_lo = k; p.ph_hi = k + 1; hipLaunchKernelGGL(hymba_fwd, dim3(grid), dim3(NTHREADS), LDS_BYTES, stream, p); }
#endif
}
```
